# Optimizing an MI355X kernel written in HIP

```python
import math
import jax, jax.numpy as jnp
from jax import lax
import numpy as np

D_MODEL = 1024
BATCH = 4
SEQ = 4096
DEPTH = 2

GRID_W = 64
HA = 8
DA = 64
QB = 128
T5_BUCKETS = 32
T5_MAX_DIST = 128
HB = 16
DB = D_MODEL // HB
NA_ROWS = 8
NA_COLS = 16
D_FF = 2816
PLE_DIM = 256
EPS = 1e-6

kernel_name = "hybrid_diffattn_natten_macaron_encoder"


def rmsnorm(x, gain):
    x32 = x.astype(jnp.float32)
    y = x32 * lax.rsqrt(jnp.mean(x32 * x32, axis=-1, keepdims=True) + EPS)
    return (y * gain.astype(jnp.float32)).astype(x.dtype)


def swiglu(h, w_in, w_out):
    gu = h @ w_in
    g, u = jnp.split(gu, 2, axis=-1)
    return (jax.nn.silu(g) * u) @ w_out


def t5_bucket(rel):
    half = T5_BUCKETS // 2
    max_exact = half // 2
    ret = jnp.where(rel > 0, half, 0)
    n = jnp.abs(rel)
    nf = jnp.maximum(n, 1).astype(jnp.float32)
    large = max_exact + (jnp.log(nf / max_exact) / math.log(T5_MAX_DIST / max_exact)
                         * (half - max_exact)).astype(jnp.int32)
    large = jnp.minimum(large, half - 1)
    return ret + jnp.where(n < max_exact, n, large)


def diff_attention(h, w_qkv, w_o, q_gain, k_gain, lam_p, subln_gain, t5_table, layer_idx):
    B, S, _ = h.shape
    lambda_init = 0.8 - 0.6 * math.exp(-0.3 * layer_idx)
    qkv = h @ w_qkv
    q, k, v = jnp.split(qkv, 3, axis=-1)
    q = rmsnorm(q.reshape(B, S, HA, 2, DA), q_gain) * (DA ** -0.5)
    k = rmsnorm(k.reshape(B, S, HA, 2, DA), k_gain)
    v = v.reshape(B, S, HA, 2 * DA)
    lp = lam_p.astype(jnp.float32)
    lam = jnp.exp(jnp.sum(lp[0] * lp[1])) - jnp.exp(jnp.sum(lp[2] * lp[3])) + lambda_init
    nblk = S // QB
    qb = q.reshape(B, nblk, QB, HA, 2, DA).transpose(1, 0, 2, 3, 4, 5)
    kpos = jnp.arange(S, dtype=jnp.int32)
    table = t5_table.astype(jnp.float32)

    def block(args):
        qblk, start = args
        qpos = start + jnp.arange(QB, dtype=jnp.int32)
        bias = table[t5_bucket(kpos[None, :] - qpos[:, None])]
        bias = bias.transpose(2, 0, 1)
        s = jnp.einsum('bqhcd,bkhcd->bhcqk', qblk, k).astype(jnp.float32)
        s = s + bias[None, :, None]
        a = jax.nn.softmax(s, axis=-1)
        a = a[:, :, 0] - lam * a[:, :, 1]
        return jnp.einsum('bhqk,bkhe->bqhe', a.astype(v.dtype), v)

    starts = jnp.arange(nblk, dtype=jnp.int32) * QB
    o = lax.map(block, (qb, starts))
    o = o.transpose(1, 0, 2, 3, 4).reshape(B, S, HA, 2 * DA)
    o = rmsnorm(o, subln_gain) * (1.0 - lambda_init)
    return o.reshape(B, S, HA * 2 * DA) @ w_o


def neighbourhood_attention(h, w_qkv, w_o, q_gain, k_gain, rpb):
    B, S, _ = h.shape
    rows = S // GRID_W
    kr = min(NA_ROWS, rows)
    qkv = h @ w_qkv
    q, k, v = jnp.split(qkv, 3, axis=-1)
    q = rmsnorm(q.reshape(B, rows, GRID_W, HB, DB), q_gain) * (DB ** -0.5)
    k = rmsnorm(k.reshape(B, rows, GRID_W, HB, DB), k_gain)
    v = v.reshape(B, rows, GRID_W, HB, DB)
    cols = jnp.arange(GRID_W, dtype=jnp.int32)
    col_start = jnp.clip(cols - NA_COLS // 2, 0, GRID_W - NA_COLS)
    col_idx = col_start[:, None] + jnp.arange(NA_COLS, dtype=jnp.int32)[None, :]
    col_off = col_idx - cols[:, None] + (NA_COLS - 1)
    rpb32 = rpb.astype(jnp.float32)

    def row_step(r):
        rs = jnp.clip(r - kr // 2, 0, rows - kr)
        kb = lax.dynamic_slice_in_dim(k, rs, kr, axis=1)
        vb = lax.dynamic_slice_in_dim(v, rs, kr, axis=1)
        kg = kb[:, :, col_idx]
        vg = vb[:, :, col_idx]
        qr = lax.dynamic_index_in_dim(q, r, axis=1, keepdims=False)
        s = jnp.einsum('bqhd,brqjhd->bhqrj', qr, kg).astype(jnp.float32)
        row_off = rs + jnp.arange(kr, dtype=jnp.int32) - r + (NA_ROWS - 1)
        bias = rpb32[:, row_off[None, :, None], col_off[:, None, :]]
        s = s + bias[None]
        a = jax.nn.softmax(s.reshape(B, HB, GRID_W, kr * NA_COLS), axis=-1)
        a = a.reshape(B, HB, GRID_W, kr, NA_COLS).astype(v.dtype)
        return jnp.einsum('bhqrj,brqjhd->bqhd', a, vg)

    o = lax.map(row_step, jnp.arange(rows, dtype=jnp.int32))
    o = o.transpose(1, 0, 2, 3, 4).reshape(B, S, HB * DB)
    return o @ w_o


def setup_inputs(seed: int = 0) -> dict:
    key = jax.random.key(seed)
    ks = jax.random.split(key, 24)
    n_a = (DEPTH + 1) // 2
    n_b = DEPTH // 2
    f32 = jnp.float32
    nrm = lambda k, shape, s: (jax.random.normal(k, shape, f32) * s)
    return {
        "x": nrm(ks[0], (BATCH, SEQ, D_MODEL), 1.0),
        "p": nrm(ks[1], (DEPTH, BATCH, SEQ, PLE_DIM), 1.0),
        "norm_gains": 1.0 + nrm(ks[2], (DEPTH, 4, D_MODEL), 0.02),
        "w_ffn_in": nrm(ks[3], (DEPTH, 2, D_MODEL, 2 * D_FF), D_MODEL ** -0.5),
        "w_ffn_out": nrm(ks[4], (DEPTH, 2, D_FF, D_MODEL), D_FF ** -0.5),
        "t5_table": nrm(ks[5], (T5_BUCKETS, HA), 0.1),
        "a_w_qkv": nrm(ks[6], (n_a, D_MODEL, 3 * D_MODEL), D_MODEL ** -0.5),
        "a_w_o": nrm(ks[7], (n_a, HA * 2 * DA, D_MODEL), D_MODEL ** -0.5),
        "a_q_gain": 1.0 + nrm(ks[8], (n_a, DA), 0.02),
        "a_k_gain": 1.0 + nrm(ks[9], (n_a, DA), 0.02),
        "a_lambda": nrm(ks[10], (n_a, 4, DA), 0.1),
        "a_subln_gain": 1.0 + nrm(ks[11], (n_a, 2 * DA), 0.02),
        "b_w_qkv": nrm(ks[12], (n_b, D_MODEL, 3 * D_MODEL), D_MODEL ** -0.5),
        "b_w_o": nrm(ks[13], (n_b, HB * DB, D_MODEL), D_MODEL ** -0.5),
        "b_q_gain": 1.0 + nrm(ks[14], (n_b, DB), 0.02),
        "b_k_gain": 1.0 + nrm(ks[15], (n_b, DB), 0.02),
        "b_rpb": nrm(ks[16], (n_b, HB, 2 * NA_ROWS - 1, 2 * NA_COLS - 1), 0.1),
        "w_ple_gate": nrm(ks[17], (DEPTH, D_MODEL, D_MODEL), D_MODEL ** -0.5),
        "b_ple_gate": nrm(ks[18], (DEPTH, D_MODEL), 0.01),
        "w_ple_proj": nrm(ks[19], (DEPTH, PLE_DIM, D_MODEL), PLE_DIM ** -0.5),
    }


def reference(x, p, norm_gains, w_ffn_in, w_ffn_out, t5_table,
              a_w_qkv, a_w_o, a_q_gain, a_k_gain, a_lambda, a_subln_gain,
              b_w_qkv, b_w_o, b_q_gain, b_k_gain, b_rpb,
              w_ple_gate, b_ple_gate, w_ple_proj):
    h = x
    for i in range(DEPTH):
        h = h + 0.5 * swiglu(rmsnorm(h, norm_gains[i, 0]), w_ffn_in[i, 0], w_ffn_out[i, 0])
        hn = rmsnorm(h, norm_gains[i, 1])
        j = i // 2
        if i % 2 == 0:
            h = h + diff_attention(hn, a_w_qkv[j], a_w_o[j], a_q_gain[j], a_k_gain[j],
                                   a_lambda[j], a_subln_gain[j], t5_table, i)
        else:
            h = h + neighbourhood_attention(hn, b_w_qkv[j], b_w_o[j], b_q_gain[j],
                                            b_k_gain[j], b_rpb[j])
        h = h + 0.5 * swiglu(rmsnorm(h, norm_gains[i, 2]), w_ffn_in[i, 1], w_ffn_out[i, 1])
        gate = jax.nn.sigmoid(rmsnorm(h, norm_gains[i, 3]) @ w_ple_gate[i] + b_ple_gate[i])
        h = h + gate * (p[i] @ w_ple_proj[i])
    return h
```

```cpp
#include <hip/hip_runtime.h>
#include <cstdio>
#include <cstdint>

namespace base {
constexpr int D = 1024, BATCH = 4, SEQ = 4096, M = BATCH * SEQ, DFF = 2816, PLE = 256;
constexpr float EPS = 1e-6f;

template <int TB>
__global__ __launch_bounds__(256) void k_gemm(const float* __restrict__ A, int lda, const float* __restrict__ B, int ldb, float* __restrict__ C, int ldc, int K) {
    __shared__ float As[16][68];
    __shared__ float Bs[16][68];
    const int tid = threadIdx.x, tx = tid & 15, ty = tid >> 4;
    const int m0 = blockIdx.y * 64, n0 = blockIdx.x * 64;
    float acc[4][4];
#pragma unroll
    for (int i = 0; i < 4; ++i)
#pragma unroll
        for (int j = 0; j < 4; ++j) acc[i][j] = 0.f;
    for (int k0 = 0; k0 < K; k0 += 16) {
        {
            const int r = tid >> 2, kk = (tid & 3) * 4;
            const float4 v = *(const float4*)(A + (size_t)(m0 + r) * lda + k0 + kk);
            As[kk + 0][r] = v.x; As[kk + 1][r] = v.y; As[kk + 2][r] = v.z; As[kk + 3][r] = v.w;
        }
        if (TB == 0) {
            const int kk = tid >> 4, nn = (tid & 15) * 4;
            const float4 v = *(const float4*)(B + (size_t)(k0 + kk) * ldb + n0 + nn);
            Bs[kk][nn + 0] = v.x; Bs[kk][nn + 1] = v.y; Bs[kk][nn + 2] = v.z; Bs[kk][nn + 3] = v.w;
        } else {
            const int nn = tid >> 2, kk = (tid & 3) * 4;
            const float4 v = *(const float4*)(B + (size_t)(n0 + nn) * ldb + k0 + kk);
            Bs[kk + 0][nn] = v.x; Bs[kk + 1][nn] = v.y; Bs[kk + 2][nn] = v.z; Bs[kk + 3][nn] = v.w;
        }
        __syncthreads();
#pragma unroll
        for (int kk = 0; kk < 16; ++kk) {
            float a[4], b[4];
#pragma unroll
            for (int i = 0; i < 4; ++i) a[i] = As[kk][ty * 4 + i];
#pragma unroll
            for (int j = 0; j < 4; ++j) b[j] = Bs[kk][tx * 4 + j];
#pragma unroll
            for (int i = 0; i < 4; ++i)
#pragma unroll
                for (int j = 0; j < 4; ++j) acc[i][j] = fmaf(a[i], b[j], acc[i][j]);
        }
        __syncthreads();
    }
#pragma unroll
    for (int i = 0; i < 4; ++i) {
        float4 v = {acc[i][0], acc[i][1], acc[i][2], acc[i][3]};
        *(float4*)(C + (size_t)(m0 + ty * 4 + i) * ldc + n0 + tx * 4) = v;
    }
}

__device__ __forceinline__ float wave_sum(float v) {
#pragma unroll
    for (int o = 1; o < 64; o <<= 1) v += __shfl_xor(v, o);
    return v;
}
__device__ __forceinline__ float wave_max(float v) {
#pragma unroll
    for (int o = 1; o < 64; o <<= 1) v = fmaxf(v, __shfl_xor(v, o));
    return v;
}

__global__ __launch_bounds__(256) void k_rmsnorm(const float* __restrict__ x, const float* __restrict__ gain, float* __restrict__ y, int rows) {
    const int lane = threadIdx.x & 63, row = blockIdx.x * 4 + (threadIdx.x >> 6);
    if (row >= rows) return;
    const float* xr = x + (size_t)row * D; float* yr = y + (size_t)row * D;
    float v[16]; float ss = 0.f;
#pragma unroll
    for (int j = 0; j < 16; ++j) { v[j] = xr[lane + 64 * j]; ss += v[j] * v[j]; }
    ss = wave_sum(ss);
    const float r = 1.0f / sqrtf(ss * (1.0f / D) + EPS);
#pragma unroll
    for (int j = 0; j < 16; ++j) yr[lane + 64 * j] = v[j] * r * gain[lane + 64 * j];
}
__global__ __launch_bounds__(256) void k_swiglu(const float* __restrict__ gu, float* __restrict__ hid, int rows) {
    const size_t n = (size_t)rows * DFF;
    for (size_t i = blockIdx.x * 256ull + threadIdx.x; i < n; i += gridDim.x * 256ull) {
        const size_t r = i / DFF, j = i % DFF;
        const float g = gu[r * (2 * DFF) + j], u = gu[r * (2 * DFF) + DFF + j];
        hid[i] = g / (1.0f + expf(-g)) * u;
    }
}
__global__ __launch_bounds__(256) void k_axpy(float* __restrict__ h, const float* __restrict__ y, float alpha, size_t n) {
    for (size_t i = blockIdx.x * 256ull + threadIdx.x; i < n; i += gridDim.x * 256ull) h[i] += alpha * y[i];
}
__global__ __launch_bounds__(256) void k_headnorm(float* __restrict__ x, int ld, int col0, int nheads, const float* __restrict__ gain, float scale, int rows) {
    const int lane = threadIdx.x & 63, row = blockIdx.x * 4 + (threadIdx.x >> 6);
    if (row >= rows) return;
    float* xr = x + (size_t)row * ld + col0;
    const float g = gain[lane] * scale;
    for (int h = 0; h < nheads; ++h) {
        const float v = xr[h * 64 + lane];
        const float ss = wave_sum(v * v);
        xr[h * 64 + lane] = v * (1.0f / sqrtf(ss * (1.0f / 64.0f) + EPS)) * g;
    }
}
__device__ __forceinline__ int t5_bucket(int rel) {
    const int n = rel < 0 ? -rel : rel;
    int b;
    if (n < 8) b = n;
    else { int l = 2 + (31 - __clz(n * n)); b = l < 15 ? l : 15; }
    return b + (rel > 0 ? 16 : 0);
}
__global__ __launch_bounds__(256) void k_softmax_diff(float* __restrict__ S0, const float* __restrict__ S1, const float* __restrict__ table, int head, const float* __restrict__ lamp) {
    __shared__ float red[8];
    __shared__ float tb[32];
    const int q = blockIdx.x, tid = threadIdx.x, lane = tid & 63, w = tid >> 6;
    if (tid < 32) tb[tid] = table[tid * 8 + head];
    float d01 = 0.f, d23 = 0.f;
    if (tid < 64) { d01 = lamp[tid] * lamp[64 + tid]; d23 = lamp[128 + tid] * lamp[192 + tid]; }
    __syncthreads();
    float* s0 = S0 + (size_t)q * SEQ; const float* s1 = S1 + (size_t)q * SEQ;
    float a[16], b[16];
    float m0 = -1e30f, m1 = -1e30f;
#pragma unroll
    for (int j = 0; j < 16; ++j) { const int k = tid + 256 * j; const float bi = tb[t5_bucket(k - q)]; a[j] = s0[k] + bi; b[j] = s1[k] + bi; m0 = fmaxf(m0, a[j]); m1 = fmaxf(m1, b[j]); }
    m0 = wave_max(m0); m1 = wave_max(m1);
    if (lane == 0) { red[w] = m0; red[4 + w] = m1; }
    __syncthreads();
    m0 = fmaxf(fmaxf(red[0], red[1]), fmaxf(red[2], red[3])); m1 = fmaxf(fmaxf(red[4], red[5]), fmaxf(red[6], red[7]));
    __syncthreads();
    float l0 = 0.f, l1 = 0.f;
#pragma unroll
    for (int j = 0; j < 16; ++j) { a[j] = expf(a[j] - m0); b[j] = expf(b[j] - m1); l0 += a[j]; l1 += b[j]; }
    l0 = wave_sum(l0); l1 = wave_sum(l1);
    if (lane == 0) { red[w] = l0; red[4 + w] = l1; }
    __syncthreads();
    l0 = (red[0] + red[1]) + (red[2] + red[3]); l1 = (red[4] + red[5]) + (red[6] + red[7]);
    __syncthreads();
    d01 = wave_sum(d01); d23 = wave_sum(d23);
    if (tid == 0) red[0] = expf(d01) - expf(d23) + 0.2f;
    __syncthreads();
    const float lam = red[0];
    const float i0 = 1.0f / l0, i1 = lam / l1;
#pragma unroll
    for (int j = 0; j < 16; ++j) s0[tid + 256 * j] = a[j] * i0 - b[j] * i1;
}
__global__ __launch_bounds__(256) void k_subln(float* __restrict__ o, const float* __restrict__ gain, int rows) {
    const int lane = threadIdx.x & 63, row = blockIdx.x * 4 + (threadIdx.x >> 6);
    if (row >= rows) return;
    float* orow = o + (size_t)row * D;
    for (int h = 0; h < 8; ++h) {
        const float v0 = orow[h * 128 + lane], v1 = orow[h * 128 + 64 + lane];
        const float ss = wave_sum(v0 * v0 + v1 * v1);
        const float r = (1.0f / sqrtf(ss * (1.0f / 128.0f) + EPS)) * 0.8f;
        orow[h * 128 + lane] = v0 * r * gain[lane]; orow[h * 128 + 64 + lane] = v1 * r * gain[64 + lane];
    }
}
__global__ __launch_bounds__(256) void k_na(const float* __restrict__ qkv, const float* __restrict__ rpb, float* __restrict__ out) {
    const int lane = threadIdx.x & 63, gw = blockIdx.x * 4 + (threadIdx.x >> 6);
    const int t = gw >> 4, h = gw & 15;
    if (t >= SEQ) return;
    const int r = t >> 6, c = t & 63;
    int rs = r - 4; rs = rs < 0 ? 0 : (rs > 56 ? 56 : rs);
    int cs = c - 8; cs = cs < 0 ? 0 : (cs > 48 ? 48 : cs);
    const float qd = qkv[(size_t)t * 3072 + h * 64 + lane];
    float m = -1e30f, l = 0.f, acc = 0.f;
    for (int i = 0; i < 8; ++i)
        for (int j = 0; j < 16; ++j) {
            const int kr = rs + i, kc = cs + j, kt = kr * 64 + kc;
            const float kd = qkv[(size_t)kt * 3072 + 1024 + h * 64 + lane];
            float s = wave_sum(qd * kd) + rpb[(h * 15 + (kr - r + 7)) * 31 + (kc - c + 15)];
            const float mn = fmaxf(m, s), f = expf(m - mn), p = expf(s - mn);
            const float vd = qkv[(size_t)kt * 3072 + 2048 + h * 64 + lane];
            l = l * f + p; acc = acc * f + p * vd; m = mn;
        }
    out[(size_t)t * D + h * 64 + lane] = acc / l;
}
__global__ __launch_bounds__(256) void k_ple(float* __restrict__ h, const float* __restrict__ g, const float* __restrict__ bias, const float* __restrict__ pr, size_t n) {
    for (size_t i = blockIdx.x * 256ull + threadIdx.x; i < n; i += gridDim.x * 256ull) {
        const float z = g[i] + bias[i & (D - 1)];
        h[i] += pr[i] / (1.0f + expf(-z));
    }
}

static void gemm(hipStream_t st, int TB, const float* A, int lda, const float* B, int ldb, float* C, int ldc, int Mr, int N, int K) {
    dim3 grid(N / 64, Mr / 64);
    if (TB == 0) hipLaunchKernelGGL(k_gemm<0>, grid, dim3(256), 0, st, A, lda, B, ldb, C, ldc, K);
    else         hipLaunchKernelGGL(k_gemm<1>, grid, dim3(256), 0, st, A, lda, B, ldb, C, ldc, K);
}
}

extern "C" void kernel_launch(void* const* d_in, const int* in_sizes, int n_in, void* d_out, int out_size, void* d_ws, size_t ws_size, hipStream_t stream) {
    using namespace base;
    const float* x = (const float*)d_in[0];
    const float* p = (const float*)d_in[1];
    const float* ng = (const float*)d_in[2];
    const float* w_in = (const float*)d_in[3];
    const float* w_out = (const float*)d_in[4];
    const float* t5 = (const float*)d_in[5];
    const float* a_wqkv = (const float*)d_in[6];
    const float* a_wo = (const float*)d_in[7];
    const float* a_qg = (const float*)d_in[8];
    const float* a_kg = (const float*)d_in[9];
    const float* a_lam = (const float*)d_in[10];
    const float* a_sub = (const float*)d_in[11];
    const float* b_wqkv = (const float*)d_in[12];
    const float* b_wo = (const float*)d_in[13];
    const float* b_qg = (const float*)d_in[14];
    const float* b_kg = (const float*)d_in[15];
    const float* b_rpb = (const float*)d_in[16];
    const float* w_gate = (const float*)d_in[17];
    const float* b_gate = (const float*)d_in[18];
    const float* w_proj = (const float*)d_in[19];
    float* h = (float*)d_out;
    float* ws = (float*)d_ws;
    const size_t R = SEQ;
    float* hn = ws;
    float* gu = hn + R * D;
    float* hid = gu + R * 2 * DFF;
    float* y = hid + R * DFF;
    float* qkv = y + R * D;
    float* ob = qkv + R * 3 * D;
    float* gg = ob + R * D;
    float* pr = gg + R * D;
    float* S0 = gu; float* S1 = gu + (size_t)SEQ * SEQ;

    hipMemcpyAsync(h, x, (size_t)M * D * sizeof(float), hipMemcpyDeviceToDevice, stream);
    const int EW = 2048;
    for (int i = 0; i < 2; ++i) {
        for (int b = 0; b < BATCH; ++b) {
            float* hb = h + (size_t)b * R * D;
            for (int f = 0; f < 2; ++f) {
                if (f == 1) {
                    hipLaunchKernelGGL(k_rmsnorm, dim3(R / 4), dim3(256), 0, stream, hb, ng + (i * 4 + 1) * D, hn, (int)R);
                    if (i == 0) {
                        gemm(stream, 0, hn, D, a_wqkv, 3 * D, qkv, 3 * D, R, 3 * D, D);
                        hipLaunchKernelGGL(k_headnorm, dim3(R / 4), dim3(256), 0, stream, qkv, 3 * D, 0, 16, a_qg, 0.125f, (int)R);
                        hipLaunchKernelGGL(k_headnorm, dim3(R / 4), dim3(256), 0, stream, qkv, 3 * D, D, 16, a_kg, 1.0f, (int)R);
                        for (int hh = 0; hh < 8; ++hh) {
                            gemm(stream, 1, qkv + hh * 128, 3 * D, qkv + D + hh * 128, 3 * D, S0, SEQ, SEQ, SEQ, 64);
                            gemm(stream, 1, qkv + hh * 128 + 64, 3 * D, qkv + D + hh * 128 + 64, 3 * D, S1, SEQ, SEQ, SEQ, 64);
                            hipLaunchKernelGGL(k_softmax_diff, dim3(SEQ), dim3(256), 0, stream, S0, S1, t5, hh, a_lam);
                            gemm(stream, 0, S0, SEQ, qkv + 2 * D + hh * 128, 3 * D, ob + hh * 128, D, SEQ, 128, SEQ);
                        }
                        hipLaunchKernelGGL(k_subln, dim3(R / 4), dim3(256), 0, stream, ob, a_sub, (int)R);
                        gemm(stream, 0, ob, D, a_wo, D, y, D, R, D, D);
                    } else {
                        gemm(stream, 0, hn, D, b_wqkv, 3 * D, qkv, 3 * D, R, 3 * D, D);
                        hipLaunchKernelGGL(k_headnorm, dim3(R / 4), dim3(256), 0, stream, qkv, 3 * D, 0, 16, b_qg, 0.125f, (int)R);
                        hipLaunchKernelGGL(k_headnorm, dim3(R / 4), dim3(256), 0, stream, qkv, 3 * D, D, 16, b_kg, 1.0f, (int)R);
                        hipLaunchKernelGGL(k_na, dim3(SEQ * 16 / 4), dim3(256), 0, stream, qkv, b_rpb, ob);
                        gemm(stream, 0, ob, D, b_wo, D, y, D, R, D, D);
                    }
                    hipLaunchKernelGGL(k_axpy, dim3(EW), dim3(256), 0, stream, hb, y, 1.0f, R * D);
                }
                hipLaunchKernelGGL(k_rmsnorm, dim3(R / 4), dim3(256), 0, stream, hb, ng + (i * 4 + (f == 0 ? 0 : 2)) * D, hn, (int)R);
                gemm(stream, 0, hn, D, w_in + (size_t)(i * 2 + f) * D * 2 * DFF, 2 * DFF, gu, 2 * DFF, R, 2 * DFF, D);
                hipLaunchKernelGGL(k_swiglu, dim3(EW), dim3(256), 0, stream, gu, hid, (int)R);
                gemm(stream, 0, hid, DFF, w_out + (size_t)(i * 2 + f) * DFF * D, D, y, D, R, D, DFF);
                hipLaunchKernelGGL(k_axpy, dim3(EW), dim3(256), 0, stream, hb, y, 0.5f, R * D);
            }
            hipLaunchKernelGGL(k_rmsnorm, dim3(R / 4), dim3(256), 0, stream, hb, ng + (i * 4 + 3) * D, hn, (int)R);
            gemm(stream, 0, hn, D, w_gate + (size_t)i * D * D, D, gg, D, R, D, D);
            gemm(stream, 0, p + ((size_t)i * M + (size_t)b * R) * PLE, PLE, w_proj + (size_t)i * PLE * D, D, pr, D, R, D, PLE);
            hipLaunchKernelGGL(k_ple, dim3(EW), dim3(256), 0, stream, hb, gg, b_gate + i * D, pr, R * D);
        }
    }
}
```

```cpp
#define MK_MODE 0

#include <hip/hip_runtime.h>
#include <cstdio>
#include <cstdint>
template <int X> __device__ __forceinline__ float xadd(float v) {
    if constexpr (X == 32) { auto rr = __builtin_amdgcn_permlane32_swap(__float_as_uint(v), __float_as_uint(v), false, false); return __uint_as_float(rr[0]) + __uint_as_float(rr[1]); }
    else return v + __int_as_float(__builtin_amdgcn_ds_swizzle(__float_as_int(v), (X << 10) | 0x1f));
}
template <int X> __device__ __forceinline__ float xmax(float v) {
    if constexpr (X == 32) { auto rr = __builtin_amdgcn_permlane32_swap(__float_as_uint(v), __float_as_uint(v), false, false); return fmaxf(__uint_as_float(rr[0]), __uint_as_float(rr[1])); }
    else return fmaxf(v, __int_as_float(__builtin_amdgcn_ds_swizzle(__float_as_int(v), (X << 10) | 0x1f)));
}
__device__ __forceinline__ float wsum64(float v) { v = xadd<1>(v); v = xadd<2>(v); v = xadd<4>(v); v = xadd<8>(v); v = xadd<16>(v); return xadd<32>(v); }
__device__ __forceinline__ float wmax64(float v) { v = xmax<1>(v); v = xmax<2>(v); v = xmax<4>(v); v = xmax<8>(v); v = xmax<16>(v); return xmax<32>(v); }
__device__ __forceinline__ int lane_id_v() { int l; asm volatile("v_mbcnt_lo_u32_b32 %0, -1, 0\n\tv_mbcnt_hi_u32_b32 %0, -1, %0" : "=v"(l)); return l; }
namespace pg8 {
#define PG8_LAS __attribute__((address_space(3)))
typedef unsigned short bf16_t;
typedef short bf16x8 __attribute__((ext_vector_type(8)));
typedef float f32x4 __attribute__((ext_vector_type(4)));
typedef unsigned u32x4 __attribute__((ext_vector_type(4)));
constexpr int BM = 256, BK = 64, HALF = 128, HTB = HALF * BK * 2  , STAGE_BYTES = 8 * HTB, NXCD = 8;

__host__ __device__ __forceinline__ int lds_byte(int r, int c) { const int st = (r >> 4) * 2 + (c >> 5), rr = r & 15, cc = c & 31, ob = rr * 64 + cc * 2; return st * 1024 + (ob ^ (((ob >> 9) & 1) << 5)); }
__host__ __device__ __forceinline__ void stage_rc(int b, int& R, int& C) { const int st = b / 1024, sb = b % 1024, swz = sb ^ (((sb >> 9) & 1) << 5); R = (st >> 1) * 16 + swz / 64; C = (st & 1) * 32 + (swz % 64) / 2; }
__host__ __device__ __forceinline__ int perm32(int rho) { const int n = rho >> 4, i = rho & 15; return 8 * (i >> 2) + 4 * n + (i & 3); }

struct Unit { int pm, pn, idx; };
struct Gemm { const bf16_t* A; const bf16_t* Bt; int M, N, K; };

struct StaticOrder {
    int nM, nN, nwg, G, c, WGM;
    __host__ __device__ void init(int M, int N, int G_, int c_, int wgm = 8) { nM = M / BM; nN = N / BM; nwg = nM * nN; G = G_; c = c_; WGM = wgm; }
    __host__ __device__ bool next(int i, Unit& u) const {
        const long L = (long)i * G + c; if (L >= nwg) return false;
        int wgid = (int)L; { const int q = nwg / NXCD, r = nwg % NXCD, xcd = wgid % NXCD, off = wgid / NXCD; wgid = (xcd < r ? xcd * (q + 1) : r * (q + 1) + (xcd - r) * q) + off; }
        const int nig = WGM * nN, gid = wgid / nig, fm = gid * WGM, gsz = (nM - fm) < WGM ? (nM - fm) : WGM;
        u.pm = fm + ((wgid % nig) % gsz); u.pn = (wgid % nig) / gsz; u.idx = i; return true;
    }
    __device__ __forceinline__ void a_ready(const Unit&) const {}
    __device__ __forceinline__ void done(const Unit&) const {}
};

__device__ __forceinline__ unsigned cvt_pk_bf16(float lo, float hi) { unsigned r; asm volatile("v_cvt_pk_bf16_f32 %0, %1, %2" : "=v"(r) : "v"(lo), "v"(hi)); return r; }
typedef float f32x2 __attribute__((ext_vector_type(2)));
typedef unsigned u32x2 __attribute__((ext_vector_type(2)));
constexpr float RMS_EPS = 1e-6f, LOG2E = 1.4426950408889634f;
__device__ __forceinline__ float fast_sigmoid(float z) { return __builtin_amdgcn_rcpf(1.0f + __builtin_amdgcn_exp2f(-z * LOG2E)); }
__device__ __forceinline__ float bf2f(unsigned short b) { return __builtin_bit_cast(float, (unsigned)b << 16); }
__device__ __forceinline__ void row_rstd(float (&rs)[2][4], const float* ssp, int row0, int fq) {
#pragma unroll
    for (int ai = 0; ai < 2; ++ai)
#pragma unroll
        for (int m = 0; m < 4; ++m) {
            const f32x4 v = *(const f32x4*)(ssp + (size_t)(row0 + ai * HALF + m * 16) * 16 + 4 * fq);
            float s = (v[0] + v[1]) + (v[2] + v[3]); s = xadd<16>(s); s = xadd<32>(s);
            rs[ai][m] = __builtin_amdgcn_rsqf(s * (1.0f / 1024.0f) + RMS_EPS);
        }
}
__device__ __forceinline__ float row_rstd1(const float* ssp, int row, int fq) {
    const f32x4 v = *(const f32x4*)(ssp + (size_t)row * 16 + 4 * fq);
    float s = (v[0] + v[1]) + (v[2] + v[3]); s = xadd<16>(s); s = xadd<32>(s);
    return __builtin_amdgcn_rsqf(s * (1.0f / 1024.0f) + RMS_EPS);
}
#ifndef MK_WT_STORES
#define MK_WT_STORES 2
#endif
__device__ __forceinline__ void store16_wt(void* p, const u32x4 v) {
#if defined(MK_WT_STORES) && MK_WT_STORES == 1
    asm volatile("global_store_dwordx4 %0, %1, off sc1\n\ts_nop 1" :: "v"(p), "v"(v) : "memory");
#elif defined(MK_WT_STORES) && MK_WT_STORES == 2
    __builtin_nontemporal_store(v, (u32x4*)p);
#else
    *(u32x4*)p = v;
#endif
}
template <class Sched> __device__ __forceinline__ void fill_rstd_table(PG8_LAS float* rsl, const float* ssp, const Sched& S, int wave, int lane, int max_units) {
    for (int task = wave; task < max_units * 4; task += 8) { Unit u; const int i = task >> 2, q = task & 3;
        if (!S.next(i, u)) break;
        const int row = u.pm * BM + 64 * q + lane; const f32x4* sp = (const f32x4*)(ssp + (size_t)row * 16);
        const f32x4 a = sp[0], b = sp[1], c = sp[2], d = sp[3];
        const float s = (((a[0] + a[1]) + (a[2] + a[3])) + ((b[0] + b[1]) + (b[2] + b[3]))) + (((c[0] + c[1]) + (c[2] + c[3])) + ((d[0] + d[1]) + (d[2] + d[3])));
        rsl[i * 256 + 64 * q + lane] = __builtin_amdgcn_rsqf(s * (1.0f / 1024.0f) + RMS_EPS); }
}
__device__ __forceinline__ void row_rstd_lds(float (&rs)[2][4], const PG8_LAS float* rsl, const Unit& u, int wr, int fr) {
#pragma unroll
    for (int ai = 0; ai < 2; ++ai)
#pragma unroll
        for (int m = 0; m < 4; ++m) rs[ai][m] = rsl[u.idx * 256 + ai * HALF + wr * 64 + m * 16 + fr];
}
struct EpiSwiGLU {
    static constexpr bool PERM = true, AFTER_DRAIN = false;
    bf16_t* hid; const PG8_LAS float* rsl;
    __device__ __forceinline__ void operator()(const f32x4 (&acc)[2][2][4][2], const Unit& u, int wr, int wc, int fr, int fq) const {
        const int row0 = u.pm * BM + wr * 64 + fr, col0 = u.pn * HALF + wc * 32 + 8 * fq;
        float rs[2][4]; row_rstd_lds(rs, rsl, u, wr, fr);
#pragma unroll
        for (int ai = 0; ai < 2; ++ai)
#pragma unroll
            for (int m = 0; m < 4; ++m) { const float r = rs[ai][m]; float o[8]; const f32x2 nr2 = {-LOG2E * r, -LOG2E * r}, rr2 = {r * r, r * r}, one2 = {1.0f, 1.0f};
#pragma unroll
                for (int n = 0; n < 2; ++n)
#pragma unroll
                    for (int e = 0; e < 4; e += 2) {
                        const f32x2 g = {acc[ai][0][m][n][e], acc[ai][0][m][n][e + 1]}, uu = {acc[ai][1][m][n][e], acc[ai][1][m][n][e + 1]};
                        const f32x2 z = g * nr2; f32x2 d = {__builtin_amdgcn_exp2f(z[0]), __builtin_amdgcn_exp2f(z[1])}; d = d + one2;
                        const f32x2 s = {__builtin_amdgcn_rcpf(d[0]), __builtin_amdgcn_rcpf(d[1])};
                        const f32x2 p = ((g * uu) * rr2) * s; o[4 * n + e] = p[0]; o[4 * n + e + 1] = p[1]; }
                u32x4 w; w.x = cvt_pk_bf16(o[0], o[1]); w.y = cvt_pk_bf16(o[2], o[3]); w.z = cvt_pk_bf16(o[4], o[5]); w.w = cvt_pk_bf16(o[6], o[7]);
                store16_wt(hid + (size_t)(row0 + ai * HALF + m * 16) * 2816 + col0, w);
                if (m & 1) asm volatile("" ::: "memory"); }
    }
};
__device__ __forceinline__ void bf8_to_f32(const u32x4 w, f32x4& a, f32x4& b) {
    a[0] = __builtin_bit_cast(float, w.x << 16); a[1] = __builtin_bit_cast(float, w.x & 0xffff0000u); a[2] = __builtin_bit_cast(float, w.y << 16); a[3] = __builtin_bit_cast(float, w.y & 0xffff0000u);
    b[0] = __builtin_bit_cast(float, w.z << 16); b[1] = __builtin_bit_cast(float, w.z & 0xffff0000u); b[2] = __builtin_bit_cast(float, w.w << 16); b[3] = __builtin_bit_cast(float, w.w & 0xffff0000u);
}
struct EpiResid {
    static constexpr bool PERM = true, AFTER_DRAIN = false;
    const bf16_t* hin; bf16_t* hout; float* ssp; float alpha;
    __device__ __forceinline__ void operator()(const f32x4 (&acc)[2][2][4][2], const Unit& u, int wr, int wc, int fr, int fq) const {
        const int row0 = u.pm * BM + wr * 64 + fr, col0 = u.pn * BM + wc * 32 + 8 * fq;
        u32x4 hv[2][4][2]; float ssr[2][4];
#pragma unroll
        for (int ai = 0; ai < 2; ++ai)
#pragma unroll
            for (int m = 0; m < 4; ++m)
#pragma unroll
                for (int bj = 0; bj < 2; ++bj) hv[ai][m][bj] = *(const u32x4*)(hin + (size_t)(row0 + ai * HALF + m * 16) * 1024 + col0 + bj * HALF);
#pragma unroll
        for (int ai = 0; ai < 2; ++ai)
#pragma unroll
            for (int m = 0; m < 4; ++m) { const int row = row0 + ai * HALF + m * 16; f32x4 q = {0.f, 0.f, 0.f, 0.f};
#pragma unroll
                for (int bj = 0; bj < 2; ++bj) { f32x4 x0, x1; bf8_to_f32(hv[ai][m][bj], x0, x1);
                    x0 = x0 + acc[ai][bj][m][0] * alpha; x1 = x1 + acc[ai][bj][m][1] * alpha;
                    u32x4 w; w.x = cvt_pk_bf16(x0[0], x0[1]); w.y = cvt_pk_bf16(x0[2], x0[3]); w.z = cvt_pk_bf16(x1[0], x1[1]); w.w = cvt_pk_bf16(x1[2], x1[3]);
                    *(u32x4*)(hout + (size_t)row * 1024 + col0 + bj * HALF) = w;
                    q += x0 * x0; q += x1 * x1; }
                ssr[ai][m] = (q[0] + q[1]) + (q[2] + q[3]); }
#pragma unroll
        for (int ai = 0; ai < 2; ++ai)
#pragma unroll
            for (int m = 0; m < 4; ++m) ssr[ai][m] = xadd<16>(ssr[ai][m]);
#pragma unroll
        for (int ai = 0; ai < 2; ++ai)
#pragma unroll
            for (int m = 0; m < 4; ++m) { const float t = xadd<32>(ssr[ai][m]); if (fq == 0) ssp[(size_t)(row0 + ai * HALF + m * 16) * 16 + u.pn * 4 + wc] = t; }
    }
};
struct EpiQKV {
    static constexpr bool PERM = true, AFTER_DRAIN = false;
    bf16_t* Q; size_t kv_stride; const PG8_LAS float* rsl; const float* qg; const float* kg; float qscale;
    __device__ __forceinline__ void operator()(const f32x4 (&acc)[2][2][4][2], const Unit& u, int wr, int wc, int fr, int fq) const {
        const int row0 = u.pm * BM + wr * 64 + fr, kind = u.pn >> 2, hcol = (u.pn & 3) * 256 + wc * 64 + 8 * fq;
        float rs[2][4]; row_rstd_lds(rs, rsl, u, wr, fr);
        bf16_t* dst = Q + (size_t)kind * kv_stride;
        f32x4 gv[2][2];
#pragma unroll
        for (int bj = 0; bj < 2; ++bj)
#pragma unroll
            for (int n = 0; n < 2; ++n) gv[bj][n] = (f32x4){1.f, 1.f, 1.f, 1.f};
        if (kind < 2) { const float* g = qg + (kg - qg) * kind; const float sc = kind == 0 ? qscale : 1.0f;
#pragma unroll
            for (int bj = 0; bj < 2; ++bj)
#pragma unroll
                for (int n = 0; n < 2; ++n) gv[bj][n] = *(const f32x4*)(g + 32 * bj + 8 * fq + 4 * n) * sc; }
        float ss[2][4];
#pragma unroll
        for (int ai = 0; ai < 2; ++ai)
#pragma unroll
            for (int m = 0; m < 4; ++m) { f32x4 q = acc[ai][0][m][0] * acc[ai][0][m][0]; q += acc[ai][0][m][1] * acc[ai][0][m][1]; q += acc[ai][1][m][0] * acc[ai][1][m][0]; q += acc[ai][1][m][1] * acc[ai][1][m][1];
                ss[ai][m] = (q[0] + q[1]) + (q[2] + q[3]); }
#pragma unroll
        for (int ai = 0; ai < 2; ++ai)
#pragma unroll
            for (int m = 0; m < 4; ++m) ss[ai][m] = xadd<16>(ss[ai][m]);
#pragma unroll
        for (int ai = 0; ai < 2; ++ai)
#pragma unroll
            for (int m = 0; m < 4; ++m) ss[ai][m] = xadd<32>(ss[ai][m]);
#pragma unroll
        for (int ai = 0; ai < 2; ++ai)
#pragma unroll
            for (int m = 0; m < 4; ++m) { const float r = rs[ai][m];
                const float hr = kind < 2 ? __builtin_amdgcn_rsqf(ss[ai][m] * (r * r) * (1.0f / 64.0f) + RMS_EPS) : 1.0f; const float sc = r * hr;
                bf16_t* rowp = dst + (size_t)(row0 + ai * HALF + m * 16) * 1024 + hcol;
#pragma unroll
                for (int bj = 0; bj < 2; ++bj) { const f32x4 v0 = acc[ai][bj][m][0] * sc * gv[bj][0], v1 = acc[ai][bj][m][1] * sc * gv[bj][1];
                    u32x4 w; w.x = cvt_pk_bf16(v0[0], v0[1]); w.y = cvt_pk_bf16(v0[2], v0[3]); w.z = cvt_pk_bf16(v1[0], v1[1]); w.w = cvt_pk_bf16(v1[2], v1[3]);
                    *(u32x4*)(rowp + 32 * bj) = w; }
                asm volatile("" ::: "memory"); }
    }
};
struct EpiPlainBf16 {
    static constexpr bool PERM = true, AFTER_DRAIN = false;
    bf16_t* O; int ldc;
    __device__ __forceinline__ void operator()(const f32x4 (&acc)[2][2][4][2], const Unit& u, int wr, int wc, int fr, int fq) const {
        const int row0 = u.pm * BM + wr * 64 + fr, col0 = u.pn * BM + wc * 32 + 8 * fq;
#pragma unroll
        for (int ai = 0; ai < 2; ++ai)
#pragma unroll
            for (int m = 0; m < 4; ++m) { bf16_t* rowp = O + (size_t)(row0 + ai * HALF + m * 16) * ldc + col0;
#pragma unroll
                for (int bj = 0; bj < 2; ++bj) { const f32x4 v0 = acc[ai][bj][m][0], v1 = acc[ai][bj][m][1];
                    u32x4 w; w.x = cvt_pk_bf16(v0[0], v0[1]); w.y = cvt_pk_bf16(v0[2], v0[3]); w.z = cvt_pk_bf16(v1[0], v1[1]); w.w = cvt_pk_bf16(v1[2], v1[3]);
                    *(u32x4*)(rowp + bj * HALF) = w; } }
    }
};
struct EpiPLE {
    static constexpr bool PERM = true, AFTER_DRAIN = false;
    const bf16_t* hin; bf16_t* hbo; float* fout; const PG8_LAS float* rsl; float* sspo; const float* bgate; const bf16_t* proj; float scale;
    __device__ __forceinline__ void operator()(const f32x4 (&acc)[2][2][4][2], const Unit& u, int wr, int wc, int fr, int fq) const {
        const int row0 = u.pm * BM + wr * 64 + fr, col0 = u.pn * BM + wc * 32 + 8 * fq;
        float rs[2][4]; row_rstd_lds(rs, rsl, u, wr, fr);
        u32x4 hv[2][2], pv[2][2]; float ssr[8];
#define PLE_LOAD(Q) do { const size_t off_ = (size_t)(row0 + ((Q) >> 2) * HALF + ((Q) & 3) * 16) * 1024 + col0; \
            _Pragma("unroll") for (int bj = 0; bj < 2; ++bj) { hv[(Q) & 1][bj] = *(const u32x4*)(hin + off_ + bj * HALF); pv[(Q) & 1][bj] = *(const u32x4*)(proj + off_ + bj * HALF); } } while (0)
#define PLE_DO(Q) do { const int ai = (Q) >> 2, m = (Q) & 3; const int row = row0 + ai * HALF + m * 16; const float r = rs[ai][m]; f32x4 q = {0.f, 0.f, 0.f, 0.f}; \
            _Pragma("unroll") for (int bj = 0; bj < 2; ++bj) { const size_t o2 = (size_t)row * 1024 + col0 + bj * HALF; \
                f32x4 x[2], pj[2]; bf8_to_f32(hv[(Q) & 1][bj], x[0], x[1]); bf8_to_f32(pv[(Q) & 1][bj], pj[0], pj[1]); \
                _Pragma("unroll") for (int n = 0; n < 2; ++n) { const f32x4 z = (acc[ai][bj][m][n] * r + *(const f32x4*)(bgate + col0 + bj * HALF + 4 * n)) * (-LOG2E); \
                    f32x4 d = {__builtin_amdgcn_exp2f(z[0]), __builtin_amdgcn_exp2f(z[1]), __builtin_amdgcn_exp2f(z[2]), __builtin_amdgcn_exp2f(z[3])}; d = d + 1.0f; \
                    const f32x4 sg = {__builtin_amdgcn_rcpf(d[0]), __builtin_amdgcn_rcpf(d[1]), __builtin_amdgcn_rcpf(d[2]), __builtin_amdgcn_rcpf(d[3])}; \
                    x[n] = x[n] + sg * (pj[n] * scale); } \
                if (fout) { __builtin_nontemporal_store(x[0], (f32x4*)(fout + o2)); __builtin_nontemporal_store(x[1], (f32x4*)(fout + o2 + 4)); } \
                else { u32x4 w; w.x = cvt_pk_bf16(x[0][0], x[0][1]); w.y = cvt_pk_bf16(x[0][2], x[0][3]); w.z = cvt_pk_bf16(x[1][0], x[1][1]); w.w = cvt_pk_bf16(x[1][2], x[1][3]); *(u32x4*)(hbo + o2) = w; } \
                q += x[0] * x[0]; q += x[1] * x[1]; } \
            ssr[Q] = (q[0] + q[1]) + (q[2] + q[3]); asm volatile("" ::: "memory"); } while (0)
        PLE_LOAD(0); PLE_LOAD(1);
        PLE_DO(0); PLE_LOAD(2); PLE_DO(1); PLE_LOAD(3); PLE_DO(2); PLE_LOAD(4); PLE_DO(3); PLE_LOAD(5); PLE_DO(4); PLE_LOAD(6); PLE_DO(5); PLE_LOAD(7); PLE_DO(6); PLE_DO(7);
#undef PLE_LOAD
#undef PLE_DO
        if (!fout) {
#pragma unroll
            for (int Q = 0; Q < 8; ++Q) ssr[Q] = xadd<16>(ssr[Q]);
#pragma unroll
            for (int Q = 0; Q < 8; ++Q) { const float t = xadd<32>(ssr[Q]); if (fq == 0) sspo[(size_t)(row0 + (Q >> 2) * HALF + (Q & 3) * 16) * 16 + u.pn * 4 + wc] = t; } }
    }
};
struct EpiNull {
    static constexpr bool PERM = true, AFTER_DRAIN = false;
    __device__ __forceinline__ void operator()(const f32x4 (&acc)[2][2][4][2], const Unit&, int, int, int, int) const {
#pragma unroll
        for (int ai = 0; ai < 2; ++ai)
#pragma unroll
            for (int bj = 0; bj < 2; ++bj)
#pragma unroll
                for (int m = 0; m < 4; ++m)
#pragma unroll
                    for (int n = 0; n < 2; ++n) asm volatile("" :: "v"(acc[ai][bj][m][n]));
    }
};
struct PairOrder {
    int c2;
    __device__ __forceinline__ bool next(int i, Unit& u) const { if (i >= 2) return false; const int id = 2 * c2 + i; u.pm = id >> 2; u.pn = id & 3; u.idx = i; return true; }
    __device__ __forceinline__ void a_ready(const Unit&) const {}
    __device__ __forceinline__ void done(const Unit&) const {}
};
template <class Epi, class Sched, bool ALIGN_EPI = false, bool SP2 = false>
__device__ __forceinline__ void gemm_phase(PG8_LAS unsigned char* lds, const Gemm g, const Sched& S, const Epi& E, const int wave_in) {
    const int lane_ = lane_id_v();
    const int wid = wave_in, lane = lane_, tid = wid * 64 + lane, wr = wid >> 2, wc = wid & 3, fr = lane & 15, fq = lane >> 4;
    const int K = g.K, nt = K / BK;
    unsigned voffA[2], voffB[2];
#pragma unroll
    for (int i = 0; i < 2; ++i) { int R, C; stage_rc(tid * 16 + i * 8192, R, C); const int Rb = Epi::PERM ? ((R & ~31) + perm32(R & 31)) : R;
        voffA[i] = (unsigned)(R * K + C) * 2u; voffB[i] = (unsigned)(Rb * K + C) * 2u; }
    const size_t kstep = (size_t)(BK * 2);
    const size_t hstep = (size_t)HALF * K * 2;
    const size_t tstep = 2 * hstep;
    const unsigned ldsw = (unsigned)wid * 1024u;
    const int aoff = lds_byte(wr * 64 + fr, fq * 8), boff = lds_byte(wc * 32 + fr, fq * 8);
#define PG8_SA(b, h) (((b) * 2 + (h)) * HTB)
#define PG8_SB(b, h) ((4 + (b) * 2 + (h)) * HTB)
#define PG8_STAGE(bufoff, gbase, voff) do { _Pragma("unroll") for (int _i = 0; _i < 2; ++_i) \
        __builtin_amdgcn_global_load_lds((const unsigned*)((const char*)(gbase) + (voff)[_i]), (PG8_LAS unsigned*)(lds + (bufoff) + ldsw + _i * 8192), 16, 0, 0); } while (0)
#define PG8_LDA(dst, b, h) do { _Pragma("unroll") for (int m = 0; m < 4; ++m) _Pragma("unroll") for (int k = 0; k < 2; ++k) dst[m][k] = *(const PG8_LAS bf16x8*)(lds + PG8_SA(b, h) + aoff + m * 2048 + k * 1024); } while (0)
#define PG8_LDB(dst, b, h) do { _Pragma("unroll") for (int n = 0; n < 2; ++n) _Pragma("unroll") for (int k = 0; k < 2; ++k) dst[n][k] = *(const PG8_LAS bf16x8*)(lds + PG8_SB(b, h) + boff + n * 2048 + k * 1024); } while (0)
#define PG8_MMA(ai, bj, At, Bt) do { __builtin_amdgcn_s_setprio(1); _Pragma("unroll") for (int m = 0; m < 4; ++m) _Pragma("unroll") for (int n = 0; n < 2; ++n) _Pragma("unroll") for (int k = 0; k < 2; ++k) \
        acc[ai][bj][m][n] = __builtin_amdgcn_mfma_f32_16x16x32_bf16(Bt[n][k], At[m][k], acc[ai][bj][m][n], 0, 0, 0); __builtin_amdgcn_s_setprio(0); } while (0)
#define PG8_WAIT_V(n) asm volatile("s_waitcnt vmcnt(" #n ")" ::: "memory")
#define PG8_WAIT_L(n) asm volatile("s_waitcnt lgkmcnt(" #n ")" ::: "memory")
#define PG8_BAR __builtin_amdgcn_s_barrier()
#define PG8_SCHED __builtin_amdgcn_sched_barrier(0)
    Unit cur, nxt; int ui = 0;
    if (!S.next(0, cur)) return;
    f32x4 acc[2][2][4][2];
#pragma unroll
    for (int a = 0; a < 2; ++a)
#pragma unroll
        for (int b = 0; b < 2; ++b)
#pragma unroll
            for (int m = 0; m < 4; ++m)
#pragma unroll
                for (int n = 0; n < 2; ++n) acc[a][b][m][n] = (f32x4){0.f, 0.f, 0.f, 0.f};
    bf16x8 At[4][2], B0[2][2], B1[2][2];
    const char* cA = (const char*)g.A + (size_t)cur.pm * tstep; const char* cB = (const char*)g.Bt + (size_t)cur.pn * tstep;
    S.a_ready(cur);
    if constexpr (SP2) {
        PG8_STAGE(PG8_SB(0, 0), cB, voffB); PG8_STAGE(PG8_SB(0, 1), cB + hstep, voffB); PG8_STAGE(PG8_SA(0, 0), cA, voffA); PG8_STAGE(PG8_SA(0, 1), cA + hstep, voffA);
        if (wr == 1) PG8_BAR;
        PG8_WAIT_V(2); PG8_BAR;
        PG8_STAGE(PG8_SB(1, 0), cB + kstep, voffB); PG8_STAGE(PG8_SA(1, 0), cA + kstep, voffA); PG8_STAGE(PG8_SB(1, 1), cB + hstep + kstep, voffB);
        PG8_WAIT_V(6); PG8_BAR;
    } else {
        PG8_STAGE(PG8_SB(0, 0), cB, voffB); PG8_STAGE(PG8_SA(0, 0), cA, voffA); PG8_STAGE(PG8_SB(0, 1), cB + hstep, voffB); PG8_STAGE(PG8_SA(0, 1), cA + hstep, voffA);
        if (wr == 1) PG8_BAR;
        PG8_WAIT_V(4); PG8_BAR;
        PG8_STAGE(PG8_SB(1, 0), cB + kstep, voffB); PG8_STAGE(PG8_SA(1, 0), cA + kstep, voffA); PG8_STAGE(PG8_SB(1, 1), cB + hstep + kstep, voffB);
        PG8_WAIT_V(6); PG8_BAR;
    }
    for (;;) {
        const bool has_next = S.next(ui + 1, nxt);
        const char* nA = has_next ? (const char*)g.A + (size_t)nxt.pm * tstep : cA; const char* nB = has_next ? (const char*)g.Bt + (size_t)nxt.pn * tstep : cB;
        for (int t = 0; t < nt; t += 2) {
            const bool last = (t == nt - 2);
            const char* a1 = cA + (size_t)(t + 1) * kstep;
            const char* a2 = last ? nA : cA + (size_t)(t + 2) * kstep; const char* b2 = last ? nB : cB + (size_t)(t + 2) * kstep;
            const char* a3 = a2 + kstep; const char* b3 = b2 + kstep;
            if (last && has_next) S.a_ready(nxt);
            if constexpr (SP2) {
            PG8_LDB(B0, 0, 0); PG8_LDB(B1, 0, 1); PG8_SCHED; PG8_LDA(At, 0, 0); PG8_STAGE(PG8_SA(1, 1), a1 + hstep, voffA);
            PG8_WAIT_V(8); PG8_WAIT_L(0); PG8_BAR; PG8_MMA(0, 0, At, B0); PG8_MMA(0, 1, At, B1); PG8_BAR; PG8_SCHED;
            PG8_LDA(At, 0, 1); PG8_STAGE(PG8_SB(0, 0), b2, voffB); PG8_STAGE(PG8_SB(0, 1), b2 + hstep, voffB); PG8_STAGE(PG8_SA(0, 0), a2, voffA);
            PG8_WAIT_V(8); PG8_WAIT_L(0); PG8_BAR; PG8_MMA(1, 0, At, B0); PG8_MMA(1, 1, At, B1); PG8_BAR; PG8_SCHED;
            PG8_LDB(B0, 1, 0); PG8_LDB(B1, 1, 1); PG8_SCHED; PG8_LDA(At, 1, 0); PG8_STAGE(PG8_SA(0, 1), a2 + hstep, voffA);
            PG8_WAIT_V(8); PG8_WAIT_L(0); PG8_BAR; PG8_MMA(0, 0, At, B0); PG8_MMA(0, 1, At, B1); PG8_BAR; PG8_SCHED;
            PG8_LDA(At, 1, 1); PG8_STAGE(PG8_SB(1, 0), b3, voffB); PG8_STAGE(PG8_SB(1, 1), b3 + hstep, voffB); PG8_STAGE(PG8_SA(1, 0), a3, voffA);
            PG8_WAIT_V(8); PG8_WAIT_L(0); PG8_BAR; PG8_MMA(1, 0, At, B0); PG8_MMA(1, 1, At, B1); PG8_BAR; PG8_SCHED;
            } else {
            PG8_LDB(B0, 0, 0); PG8_SCHED; PG8_LDA(At, 0, 0); PG8_STAGE(PG8_SA(1, 1), a1 + hstep, voffA);
            PG8_WAIT_L(8); PG8_BAR; PG8_WAIT_L(0); PG8_MMA(0, 0, At, B0); PG8_BAR; PG8_SCHED;
            PG8_LDB(B1, 0, 1); PG8_STAGE(PG8_SB(0, 0), b2, voffB);
            PG8_BAR; PG8_WAIT_L(0); PG8_MMA(0, 1, At, B1); PG8_BAR;
            PG8_LDA(At, 0, 1); PG8_STAGE(PG8_SA(0, 0), a2, voffA);
            PG8_BAR; PG8_WAIT_L(0); PG8_MMA(1, 0, At, B0); PG8_BAR; PG8_SCHED;
            PG8_STAGE(PG8_SB(0, 1), b2 + hstep, voffB);
            PG8_WAIT_V(6); PG8_BAR; PG8_MMA(1, 1, At, B1); PG8_BAR;
            PG8_LDB(B0, 1, 0); PG8_SCHED; PG8_LDA(At, 1, 0); PG8_STAGE(PG8_SA(0, 1), a2 + hstep, voffA);
            PG8_WAIT_L(8); PG8_BAR; PG8_WAIT_L(0); PG8_MMA(0, 0, At, B0); PG8_BAR; PG8_SCHED;
            PG8_LDB(B1, 1, 1); PG8_STAGE(PG8_SB(1, 0), b3, voffB);
            PG8_BAR; PG8_WAIT_L(0); PG8_MMA(0, 1, At, B1); PG8_BAR;
            PG8_LDA(At, 1, 1); PG8_STAGE(PG8_SA(1, 0), a3, voffA);
            PG8_BAR; PG8_WAIT_L(0); PG8_MMA(1, 0, At, B0); PG8_BAR; PG8_SCHED;
            PG8_STAGE(PG8_SB(1, 1), b3 + hstep, voffB);
            PG8_WAIT_V(6); PG8_BAR; PG8_MMA(1, 1, At, B1); PG8_BAR;
            }
        }
        if constexpr (ALIGN_EPI) { if (wr == 0) PG8_BAR; }
        if constexpr (!Epi::AFTER_DRAIN) { E(acc, cur, wr, wc, fr, fq); S.done(cur); }
        if (!has_next) break;
#pragma unroll
        for (int a = 0; a < 2; ++a)
#pragma unroll
            for (int b = 0; b < 2; ++b)
#pragma unroll
                for (int m = 0; m < 4; ++m)
#pragma unroll
                    for (int n = 0; n < 2; ++n) acc[a][b][m][n] = (f32x4){0.f, 0.f, 0.f, 0.f};
        cur = nxt; cA = nA; cB = nB; ++ui;
        if constexpr (ALIGN_EPI) { if (wr == 1) PG8_BAR; }
    }
    PG8_WAIT_V(0);
    if constexpr (!ALIGN_EPI) { if (wr == 0) PG8_BAR; }
    PG8_BAR;
    if constexpr (Epi::AFTER_DRAIN) { E.fused(acc, cur, wr, wc, fr, fq, lds, wid, lane); S.done(cur); }
#undef PG8_SA
#undef PG8_SB
#undef PG8_STAGE
#undef PG8_LDA
#undef PG8_LDB
#undef PG8_MMA
#undef PG8_WAIT_V
#undef PG8_WAIT_L
#undef PG8_BAR
#undef PG8_SCHED
}
}
namespace att {
typedef unsigned short bf16_t;
using bf16x8 = __attribute__((ext_vector_type(8))) short;
using s16x4 = __attribute__((ext_vector_type(4))) short;
using f32x16 = __attribute__((ext_vector_type(16))) float;
using f32x4 = __attribute__((ext_vector_type(4))) float;
using u32x4 = __attribute__((ext_vector_type(4))) unsigned;
typedef short v4i16_t __attribute__((ext_vector_type(4)));
typedef __attribute__((address_space(3))) const char* lds_cptr;
typedef __attribute__((address_space(3))) char* lds_ptr;
typedef __attribute__((address_space(3))) float* lds_fptr;
constexpr int SEQ = 4096, DM = 1024, KVBLK = 64, NT = SEQ / KVBLK;
constexpr float L2E = 1.4426950408889634f, EPS = 1e-6f;
#define SBAR() __builtin_amdgcn_sched_barrier(0)
__device__ __forceinline__ int crow(int r, int hi) { return (r & 3) + 8 * (r >> 2) + 4 * hi; }
__device__ __forceinline__ void glds16(const void* gsrc, unsigned lds_dst) { unsigned keep;
    asm volatile("s_mov_b32 %0, m0\n\ts_mov_b32 m0, %2\n\ts_nop 0\n\tglobal_load_lds_dwordx4 %1, off\n\ts_mov_b32 m0, %0" : "=&s"(keep) : "v"(gsrc), "s"(lds_dst) : "memory"); }
typedef float f32x2_t __attribute__((ext_vector_type(2))); typedef __bf16 bf16x2_t __attribute__((ext_vector_type(2)));
__device__ __forceinline__ unsigned cvtpk(float lo, float hi) { f32x2_t v = {lo, hi}; bf16x2_t b = __builtin_convertvector(v, bf16x2_t); return __builtin_bit_cast(unsigned, b); }
__device__ __forceinline__ s16x4 vtr(lds_cptr p) { return __builtin_bit_cast(s16x4, __builtin_amdgcn_ds_read_tr16_b64_v4i16((__attribute__((address_space(3))) v4i16_t*)p)); }
#define WAIT_BAR(N) asm volatile("s_waitcnt vmcnt(" #N ") lgkmcnt(0)\n\ts_barrier" ::: "memory")
__device__ __forceinline__ float wave_max(float v) { return wmax64(v); }
__device__ __forceinline__ float wave_sum(float v) { return wsum64(v); }
__device__ __forceinline__ int t5_bucket(int rel) {
    const int n = rel < 0 ? -rel : rel; int b;
    if (n < 8) b = n; else { const int l = 2 + (31 - __clz(n * n)); b = l < 15 ? l : 15; }
    return b + (rel > 0 ? 16 : 0);
}

constexpr int D_SLOT = 32768, D_NSLOT = 3, D_STG = 17408;
template <int PROBE = 0  >
__device__ __forceinline__ void d_unit(int b, int h, int qb, const bf16_t* Q, const bf16_t* K, const bf16_t* V, bf16_t* O, const float* t5, const float* qg, const float* kg,
                                       const float* lamp, char* shm, char* aux, const int wave_in, const int tmask = -1  ) {
    const int lane_ = lane_id_v();
    const int lane = lane_, tid = wave_in * 64 + lane, r32 = lane & 31, hi = lane >> 5;
    const int wid = wave_in, qi = wid & 3, c = wid >> 2;
    const long rowbase = (long)b * SEQ; const int q0 = qb * 128 + qi * 32;
    const lds_fptr tbl = (lds_fptr)aux; const lds_fptr wsf = (lds_fptr)(aux + 1024) + wid * 64;
    const float c_lo = t5[15 * 8 + h] * L2E, c_hi = t5[31 * 8 + h] * L2E;
    if (tid < 256) tbl[tid] = t5[t5_bucket(tid - 128) * 8 + h] * L2E - c_hi;
    const float fscale = __builtin_amdgcn_exp2f(c_lo - c_hi);
    const float lam = expf(wave_sum(lamp[lane] * lamp[64 + lane])) - expf(wave_sum(lamp[128 + lane] * lamp[192 + lane])) + 0.2f;
    const unsigned lds0 = (unsigned)(uintptr_t)shm;
    const bf16_t* ksrc = (PROBE & 64) ? K + rowbase * DM + h * 128 + wid * 512 + lane * 8 : K + (rowbase + lane) * DM + h * 128 + wid * 8;
    const bf16_t* vsrc = (PROBE & 64) ? V + rowbase * DM + h * 128 + wid * 512 + lane * 8 : V + (rowbase + 16 * (wid & 3) + (lane >> 2)) * DM + h * 128 + (wid >> 2) * 32 + (lane & 3) * 8;
    const unsigned dst0 = lds0 + wid * 1024;
#define DMA_K(t, slot) do { const bf16_t* ks_ = ksrc + (long)((t) & tmask) * KVBLK * DM; const unsigned d_ = (unsigned)__builtin_amdgcn_readfirstlane(dst0 + (slot)); glds16(ks_, d_); glds16(ks_ + 64, d_ + 8192); } while (0)
#define DMA_V(t, slot) do { const bf16_t* vs_ = vsrc + (long)((t) & tmask) * KVBLK * DM; const unsigned d_ = (unsigned)__builtin_amdgcn_readfirstlane(dst0 + (slot)); glds16(vs_, d_ + 16384); glds16(vs_ + 64, d_ + 24576); } while (0)
#define DMA1(t, slot, which) do { const unsigned d_ = (unsigned)__builtin_amdgcn_readfirstlane(dst0 + (slot)); \
        if ((which) == 0) glds16(ksrc + (long)((t) & tmask) * KVBLK * DM, d_); else if ((which) == 1) glds16(ksrc + (long)((t) & tmask) * KVBLK * DM + 64, d_ + 8192); \
        else if ((which) == 2) glds16(vsrc + (long)((t) & tmask) * KVBLK * DM, d_ + 16384); else glds16(vsrc + (long)((t) & tmask) * KVBLK * DM + 64, d_ + 24576); } while (0)
    const bf16_t* Qw = Q + (rowbase + q0 + r32) * DM + h * 128 + c * 64 + hi * 8;
    bf16x8 qr[4];
#pragma unroll
    for (int d0 = 0; d0 < 4; ++d0) qr[d0] = *(const bf16x8*)(Qw + d0 * 16);
    DMA_K(0, 0); DMA_V(0, 0); DMA_K(1, D_SLOT); DMA_K(2, 2 * D_SLOT);
    const lds_cptr shm3 = (lds_cptr)shm;
    const lds_cptr kp0 = shm3 + c * 8192 + hi * 1024 + r32 * 16;
    const lds_cptr vp0 = shm3 + 16384 + ((lane >> 4) & 1) * 32 + (lane & 3) * 8 + (4 * hi + ((lane & 15) >> 2)) * 64;
    f32x16 o[4]; o[0] = f32x16{}; o[1] = f32x16{}; o[2] = f32x16{}; o[3] = f32x16{};
    float l_reg = 0.f;
    const int tb0 = q0 >= 154 ? ((q0 - 154) >> 6) + 1 : 0; int tb1 = (q0 + 122 + 63) >> 6; tb1 = tb1 > NT ? NT : tb1;
    const int relq = 128 - (q0 + r32);
    bf16x8 kf[8]; f32x16 C0, C1; const f32x16 zero16 = f32x16{};
    s16x4 vlo[8], vhi[8]; u32x4 pa0, pa1, pa2, pa3, pb0, pb1, pb2, pb3;
#define KLD(j, kp) do { kf[2 * (j)] = *(const __attribute__((address_space(3))) bf16x8*)((kp) + (j) * 2048); kf[2 * (j) + 1] = *(const __attribute__((address_space(3))) bf16x8*)((kp) + (j) * 2048 + 512); } while (0)
#define BAND_ADD(t) do { const int rb_ = 64 * (t) + relq; \
        _Pragma("unroll") for (int r = 0; r < 16; ++r) { int i0 = rb_ + crow(r, hi); int i1 = i0 + 32; \
            i0 = i0 < 0 ? 0 : (i0 > 255 ? 255 : i0); i1 = i1 < 0 ? 0 : (i1 > 255 ? 255 : i1); C0[r] += tbl[i0]; C1[r] += tbl[i1]; } } while (0)
#define EX(v) ((PROBE & 1) ? (v) * 0.001f : __builtin_amdgcn_exp2f(v))
#define PIN(x) asm volatile("" : "+v"(x))
    WAIT_BAR(6);
    KLD(0, kp0); KLD(1, kp0); KLD(2, kp0); KLD(3, kp0);
#pragma unroll
    for (int d0 = 0; d0 < 4; ++d0) {
        if (d0 == 0) { C0 = __builtin_amdgcn_mfma_f32_32x32x16_bf16(kf[0], qr[0], zero16, 0, 0, 0); C1 = __builtin_amdgcn_mfma_f32_32x32x16_bf16(kf[1], qr[0], zero16, 0, 0, 0); }
        else { C0 = __builtin_amdgcn_mfma_f32_32x32x16_bf16(kf[2 * d0], qr[d0], C0, 0, 0, 0); C1 = __builtin_amdgcn_mfma_f32_32x32x16_bf16(kf[2 * d0 + 1], qr[d0], C1, 0, 0, 0); } }
    if (0 >= tb0 && 0 < tb1) BAND_ADD(0);
    {
#pragma unroll
      for (int r = 0; r < 16; ++r) { C0[r] = EX(C0[r]); C1[r] = EX(C1[r]); }
      pa0 = (u32x4){cvtpk(C0[0], C0[1]), cvtpk(C0[2], C0[3]), cvtpk(C0[4], C0[5]), cvtpk(C0[6], C0[7])}; pa1 = (u32x4){cvtpk(C0[8], C0[9]), cvtpk(C0[10], C0[11]), cvtpk(C0[12], C0[13]), cvtpk(C0[14], C0[15])};
      pa2 = (u32x4){cvtpk(C1[0], C1[1]), cvtpk(C1[2], C1[3]), cvtpk(C1[4], C1[5]), cvtpk(C1[6], C1[7])}; pa3 = (u32x4){cvtpk(C1[8], C1[9]), cvtpk(C1[10], C1[11]), cvtpk(C1[12], C1[13]), cvtpk(C1[14], C1[15])}; }
    WAIT_BAR(0);
    DMA_K(3, 0); DMA_V(1, D_SLOT);
    KLD(0, kp0 + D_SLOT); KLD(1, kp0 + D_SLOT); KLD(2, kp0 + D_SLOT); KLD(3, kp0 + D_SLOT);
    WAIT_BAR(4);
    int sl_prev = 0, sl_cur = D_SLOT, sl_next = 2 * D_SLOT;
#define VFR(i) (bf16x8){vlo[i][0], vlo[i][1], vlo[i][2], vlo[i][3], vhi[i][0], vhi[i][1], vhi[i][2], vhi[i][3]}
#define VRD(j) do { if ((PROBE & 2) && (j) > 7) break; vlo[(j) & 7] = vtr(vp_ + ((((j) & 3) * 4 + ((j) >> 2)) * 1024)); vhi[(j) & 7] = vtr(vp_ + ((((j) & 3) * 4 + ((j) >> 2)) * 1024 + 512)); } while (0)
#define DOT2(W) asm volatile("v_dot2c_f32_bf16 %0, %1, %2" : "+v"(sacc) : "v"(W), "v"(0x3f803f80u))
#define GAPA(MF, J, W0, W1) do { MF; VRD(J); DOT2(W0); DOT2(W1); SBAR(); } while (0)
#define GAPB(J, PCK, PNK, CS, B) do { if (!(PROBE & 8)) o[(J) & 3] = __builtin_amdgcn_mfma_f32_32x32x16_bf16(__builtin_bit_cast(bf16x8, PCK), VFR((J) & 7), o[(J) & 3], 0, 0, 0); \
        { const float e0_ = EX(CS[B]), e1_ = EX(CS[(B) + 1]); PNK[(J) & 3] = cvtpk(e0_, e1_); PIN(PNK); } } while (0)
#define STEP(t, PC0, PC1, PC2, PC3, PN0, PN1, PN2, PN3) do { SBAR(); \
        const lds_cptr vp_ = vp0 + sl_prev; float sacc = 0.f; \
          \
        GAPA(C0 = __builtin_amdgcn_mfma_f32_32x32x16_bf16(kf[0], qr[0], zero16, 0, 0, 0), 0, PC0[0], PC0[1]); \
        GAPA(C1 = __builtin_amdgcn_mfma_f32_32x32x16_bf16(kf[1], qr[0], zero16, 0, 0, 0), 1, PC0[2], PC0[3]); \
        GAPA(C0 = __builtin_amdgcn_mfma_f32_32x32x16_bf16(kf[2], qr[1], C0, 0, 0, 0),     2, PC1[0], PC1[1]); \
        GAPA(C1 = __builtin_amdgcn_mfma_f32_32x32x16_bf16(kf[3], qr[1], C1, 0, 0, 0),     3, PC1[2], PC1[3]); \
        GAPA(C0 = __builtin_amdgcn_mfma_f32_32x32x16_bf16(kf[4], qr[2], C0, 0, 0, 0),     4, PC2[0], PC2[1]); \
        GAPA(C1 = __builtin_amdgcn_mfma_f32_32x32x16_bf16(kf[5], qr[2], C1, 0, 0, 0),     5, PC2[2], PC2[3]); \
        GAPA(C0 = __builtin_amdgcn_mfma_f32_32x32x16_bf16(kf[6], qr[3], C0, 0, 0, 0),     6, PC3[0], PC3[1]); \
        GAPA(C1 = __builtin_amdgcn_mfma_f32_32x32x16_bf16(kf[7], qr[3], C1, 0, 0, 0),     7, PC3[2], PC3[3]); \
        l_reg += sacc; \
        if (!(PROBE & 16)) { if ((t) + 3 < NT) DMA_K((t) + 3, sl_cur);               \
        if ((t) + 1 < NT) DMA_V((t) + 1, sl_next); }            \
        if (!(PROBE & 32) && (t) >= tb0 && (t) < tb1) BAND_ADD(t); \
        SBAR(); \
          \
        const lds_cptr kn_ = kp0 + sl_next; const bool gl_ = (t) + 1 < NT; \
        GAPB(0, PC0, PN0, C0, 0);   VRD(8);  \
        GAPB(1, PC0, PN0, C0, 2);   VRD(9);  \
        GAPB(2, PC0, PN0, C0, 4);   VRD(10); \
        GAPB(3, PC0, PN0, C0, 6);   VRD(11); SBAR(); \
        GAPB(4, PC1, PN1, C0, 8);   VRD(12); \
        GAPB(5, PC1, PN1, C0, 10);  VRD(13); \
        GAPB(6, PC1, PN1, C0, 12);  VRD(14); \
        GAPB(7, PC1, PN1, C0, 14);  VRD(15); SBAR(); \
        GAPB(8, PC2, PN2, C1, 0);   if (gl_ && !(PROBE & 4)) KLD(0, kn_); \
        GAPB(9, PC2, PN2, C1, 2);   if (gl_ && !(PROBE & 4)) KLD(1, kn_); \
        GAPB(10, PC2, PN2, C1, 4);  if (gl_ && !(PROBE & 4)) KLD(2, kn_); \
        GAPB(11, PC2, PN2, C1, 6);  if (gl_ && !(PROBE & 4)) KLD(3, kn_); SBAR(); \
        GAPB(12, PC3, PN3, C1, 8);  \
        GAPB(13, PC3, PN3, C1, 10); \
        GAPB(14, PC3, PN3, C1, 12); \
        GAPB(15, PC3, PN3, C1, 14); SBAR(); \
        if ((t) == tb0 && tb0 > 0) {                            \
            l_reg *= fscale; \
            _Pragma("unroll") for (int d_ = 0; d_ < 4; ++d_) _Pragma("unroll") for (int r = 0; r < 16; ++r) o[d_][r] *= fscale; } \
          \
        if ((t) + 3 < NT) { WAIT_BAR(4); } else if ((t) + 1 < NT) { WAIT_BAR(2); } else { WAIT_BAR(0); } \
        sl_prev = sl_cur; sl_cur = sl_next; sl_next = (sl_next == (D_NSLOT - 1) * D_SLOT) ? 0 : sl_next + D_SLOT; } while (0)
    int t = 1;
#pragma unroll 1
    for (; t + 1 < NT; t += 2) {
        STEP(t, pa0, pa1, pa2, pa3, pb0, pb1, pb2, pb3);
        STEP(t + 1, pb0, pb1, pb2, pb3, pa0, pa1, pa2, pa3);
    }
    STEP(t, pa0, pa1, pa2, pa3, pb0, pb1, pb2, pb3);
    { const lds_cptr vp_ = vp0 + sl_prev; float sacc = 0.f;
#pragma unroll
      for (int i_ = 0; i_ < 4; ++i_) { DOT2(pb0[i_]); DOT2(pb1[i_]); DOT2(pb2[i_]); DOT2(pb3[i_]); }
      l_reg += sacc;
#pragma unroll
      for (int d0 = 0; d0 < 4; ++d0) {
#define PV1(KS, PW) do { const s16x4 lo_ = vtr(vp_ + (d0 * 4 + (KS)) * 1024), hh_ = vtr(vp_ + (d0 * 4 + (KS)) * 1024 + 512); \
          o[d0] = __builtin_amdgcn_mfma_f32_32x32x16_bf16(__builtin_bit_cast(bf16x8, PW), (bf16x8){lo_[0], lo_[1], lo_[2], lo_[3], hh_[0], hh_[1], hh_[2], hh_[3]}, o[d0], 0, 0, 0); } while (0)
          PV1(0, pb0); PV1(1, pb1); PV1(2, pb2); PV1(3, pb3);
#undef PV1
      } }
#undef STEP
#undef GAPA
#undef DOT2
#undef GAPB
#undef VFR
#undef VRD
#undef PIN
#undef EX
#undef KLD
#undef BAND_ADD
#undef DMA_K
#undef DMA1
#undef DMA_V
    { auto rr = __builtin_amdgcn_permlane32_swap(__float_as_uint(l_reg), __float_as_uint(l_reg), false, false); l_reg = __uint_as_float(rr[0]) + __uint_as_float(rr[1]); }
    if (hi == 0) wsf[r32] = l_reg;
    asm volatile("s_waitcnt lgkmcnt(0)" ::: "memory");
    float rli[16];
#pragma unroll
    for (int r = 0; r < 16; ++r) rli[r] = (c == 0 ? 1.0f : lam) / wsf[crow(r, hi)];
    asm volatile("s_waitcnt lgkmcnt(0)\n\ts_barrier" ::: "memory");
    const lds_fptr stg = (lds_fptr)(shm + qi * D_STG);
    if (c == 1) {
#pragma unroll
        for (int d0 = 0; d0 < 4; ++d0)
#pragma unroll
            for (int r = 0; r < 16; ++r) stg[(d0 * 16 + r) * 64 + lane] = o[d0][r] * rli[r];
    }
    asm volatile("s_waitcnt lgkmcnt(0)\n\ts_barrier" ::: "memory");
    if (c == 0) {
#pragma unroll
        for (int d0 = 0; d0 < 4; ++d0)
#pragma unroll
            for (int r = 0; r < 16; ++r) o[d0][r] = o[d0][r] * rli[r] - stg[(d0 * 16 + r) * 64 + lane];
        asm volatile("s_waitcnt lgkmcnt(0)" ::: "memory");
#pragma unroll
        for (int d0 = 0; d0 < 4; ++d0)
#pragma unroll
            for (int r = 0; r < 16; ++r) stg[crow(r, hi) * 132 + d0 * 32 + r32] = o[d0][r];
        asm volatile("s_waitcnt lgkmcnt(0)" ::: "memory");
        const int row = lane >> 1, half = lane & 1;
        f32x4 v[16]; float ss = 0.f;
#pragma unroll
        for (int i = 0; i < 16; ++i) { v[i] = *(const __attribute__((address_space(3))) f32x4*)(stg + row * 132 + half * 64 + 4 * i); ss += (v[i][0] * v[i][0] + v[i][1] * v[i][1]) + (v[i][2] * v[i][2] + v[i][3] * v[i][3]); }
        ss = xadd<1>(ss);
        const float rn = 1.0f / sqrtf(ss * (1.0f / 128.0f) + EPS);
        bf16_t* Ow = O + (rowbase + q0 + row) * DM + h * 128 + half * 64;
#pragma unroll
        for (int i = 0; i < 8; ++i) { const f32x4 a = v[2 * i] * rn, bq = v[2 * i + 1] * rn;
            u32x4 w = {cvtpk(a[0], a[1]), cvtpk(a[2], a[3]), cvtpk(bq[0], bq[1]), cvtpk(bq[2], bq[3])};
            *(u32x4*)(Ow + 8 * i) = w; }
    }
    asm volatile("s_waitcnt lgkmcnt(0)\n\ts_barrier" ::: "memory");
}

constexpr int S_KSLOT = 16384, S_NK = 3, S_VBASE = 49152, S_VSLOT = 16384, S_NV = 4;
template <int PROBE = 0>
__device__ __forceinline__ void d_unit_s(int b, int h, int qb, const bf16_t* Q, const bf16_t* K, const bf16_t* V, bf16_t* O, const float* t5, const float* qg, const float* kg,
                                         const float* lamp, char* shm, char* aux, const int wave_in) {
    const int lane_ = lane_id_v();
    const int lane = lane_, tid = wave_in * 64 + lane, r32 = lane & 31, hi = lane >> 5;
    const int wid = wave_in, qi = wid & 3, c = wid >> 2;
    const long rowbase = (long)b * SEQ; const int q0 = qb * 128 + qi * 32;
    const lds_fptr tbl = (lds_fptr)aux; const lds_fptr wsf = (lds_fptr)(aux + 1024) + wid * 64;
    const float c_lo = t5[15 * 8 + h] * L2E, c_hi = t5[31 * 8 + h] * L2E;
    if (tid < 256) tbl[tid] = t5[t5_bucket(tid - 128) * 8 + h] * L2E - c_hi;
    const float fscale = __builtin_amdgcn_exp2f(c_lo - c_hi);
    const unsigned lds0 = (unsigned)(uintptr_t)shm;
    const bf16_t* ksrc = K + (rowbase + lane) * DM + h * 128 + wid * 8;
    const bf16_t* vsrc = V + (rowbase + 16 * (wid & 3) + (lane >> 2)) * DM + h * 128 + (wid >> 2) * 32 + (lane & 3) * 8;
    const unsigned dst0 = lds0 + wid * 1024;
#define SDMA_K(t, ks) do { const bf16_t* s_ = ksrc + (long)(t) * KVBLK * DM; const unsigned d_ = (dst0 + (ks) * S_KSLOT); glds16(s_, d_); glds16(s_ + 64, d_ + 8192); } while (0)
#define SDMA_V(t, vs) do { const bf16_t* s_ = vsrc + (long)(t) * KVBLK * DM; const unsigned d_ = (dst0 + S_VBASE + (vs) * S_VSLOT); glds16(s_, d_); glds16(s_ + 64, d_ + 8192); } while (0)
    const bf16_t* Qw = Q + (rowbase + q0 + r32) * DM + h * 128 + c * 64 + hi * 8;
    bf16x8 qr[4];
#pragma unroll
    for (int d0 = 0; d0 < 4; ++d0) qr[d0] = *(const bf16x8*)(Qw + d0 * 16);
    const bf16_t* kq = ksrc; const bf16_t* vq = vsrc;
#define SDMA_KQ(ks) do { const unsigned d_ = (dst0 + (ks) * S_KSLOT); glds16(kq, d_); glds16(kq + 64, d_ + 8192); kq += KVBLK * DM; } while (0)
#define SDMA_VQ(vs) do { const unsigned d_ = (dst0 + S_VBASE + (vs) * S_VSLOT); glds16(vq, d_); glds16(vq + 64, d_ + 8192); vq += KVBLK * DM; } while (0)
    SDMA_KQ(0); SDMA_KQ(1); SDMA_VQ(0); SDMA_KQ(2); SDMA_VQ(1);
    const lds_cptr shm3 = (lds_cptr)shm;
    const lds_cptr kp0 = shm3 + c * 8192 + hi * 1024 + r32 * 16;
    const lds_cptr vp0 = shm3 + S_VBASE + ((lane >> 4) & 1) * 32 + (lane & 3) * 8 + (4 * hi + ((lane & 15) >> 2)) * 64;
    f32x16 o[4]; o[0] = f32x16{}; o[1] = f32x16{}; o[2] = f32x16{}; o[3] = f32x16{};
    float l_reg = 0.f;
    const int tb0 = q0 >= 154 ? ((q0 - 154) >> 6) + 1 : 0; int tb1 = (q0 + 122 + 63) >> 6; tb1 = tb1 > NT ? NT : tb1;
    const int relq = 128 - (q0 + r32);
    bf16x8 F[8]; f32x16 C0, C1; const f32x16 zero16 = f32x16{};
    u32x4 pa0, pa1, pa2, pa3, pb0, pb1, pb2, pb3;
#define EX(v) __builtin_amdgcn_exp2f(v)
#define PIN(x) asm volatile("" : "+v"(x))
#define DOT2(W) asm volatile("v_dot2c_f32_bf16 %0, %1, %2" : "+v"(sacc) : "v"(W), "v"(0x3f803f80u))
#define BAND_ADD(t) do { const int rb_ = 64 * (t) + relq; \
        _Pragma("unroll") for (int r = 0; r < 16; ++r) { int i0 = rb_ + crow(r, hi); int i1 = i0 + 32; \
            i0 = i0 < 0 ? 0 : (i0 > 255 ? 255 : i0); i1 = i1 < 0 ? 0 : (i1 > 255 ? 255 : i1); C0[r] += tbl[i0]; C1[r] += tbl[i1]; } } while (0)
#define S_LK(t) do { const lds_cptr kp_ = kp0 + ((t) % S_NK) * S_KSLOT; _Pragma("unroll") for (int j = 0; j < 4; ++j) { \
        F[2 * j] = *(const __attribute__((address_space(3))) bf16x8*)(kp_ + j * 2048); F[2 * j + 1] = *(const __attribute__((address_space(3))) bf16x8*)(kp_ + j * 2048 + 512); } } while (0)
#define S_LV(tv, DB0) do { const lds_cptr vp_ = vp0 + ((tv) % S_NV) * S_VSLOT; _Pragma("unroll") for (int j = 0; j < 8; ++j) { \
        const s16x4 lo_ = vtr(vp_ + (((DB0) + (j & 1)) * 4 + (j >> 1)) * 1024), hh_ = vtr(vp_ + (((DB0) + (j & 1)) * 4 + (j >> 1)) * 1024 + 512); \
        F[j] = (bf16x8){lo_[0], lo_[1], lo_[2], lo_[3], hh_[0], hh_[1], hh_[2], hh_[3]}; } } while (0)
#define S_QK(PC0, PC1, PC2, PC3) do { float sacc = 0.f; SBAR(); \
        C0 = __builtin_amdgcn_mfma_f32_32x32x16_bf16(F[0], qr[0], zero16, 0, 0, 0); DOT2(PC0[0]); DOT2(PC0[1]); SBAR(); \
        C1 = __builtin_amdgcn_mfma_f32_32x32x16_bf16(F[1], qr[0], zero16, 0, 0, 0); DOT2(PC0[2]); DOT2(PC0[3]); SBAR(); \
        C0 = __builtin_amdgcn_mfma_f32_32x32x16_bf16(F[2], qr[1], C0, 0, 0, 0);     DOT2(PC1[0]); DOT2(PC1[1]); SBAR(); \
        C1 = __builtin_amdgcn_mfma_f32_32x32x16_bf16(F[3], qr[1], C1, 0, 0, 0);     DOT2(PC1[2]); DOT2(PC1[3]); SBAR(); \
        C0 = __builtin_amdgcn_mfma_f32_32x32x16_bf16(F[4], qr[2], C0, 0, 0, 0);     DOT2(PC2[0]); DOT2(PC2[1]); SBAR(); \
        C1 = __builtin_amdgcn_mfma_f32_32x32x16_bf16(F[5], qr[2], C1, 0, 0, 0);     DOT2(PC2[2]); DOT2(PC2[3]); SBAR(); \
        C0 = __builtin_amdgcn_mfma_f32_32x32x16_bf16(F[6], qr[3], C0, 0, 0, 0);     DOT2(PC3[0]); DOT2(PC3[1]); SBAR(); \
        C1 = __builtin_amdgcn_mfma_f32_32x32x16_bf16(F[7], qr[3], C1, 0, 0, 0);     DOT2(PC3[2]); DOT2(PC3[3]); SBAR(); \
        l_reg += sacc; } while (0)
#define S_PVG(J, OB, PCK, PNK, CS) do { o[(OB) + ((J) & 1)] = __builtin_amdgcn_mfma_f32_32x32x16_bf16(__builtin_bit_cast(bf16x8, PCK), F[J], o[(OB) + ((J) & 1)], 0, 0, 0); \
        { const float e0_ = EX(CS[2 * (J)]), e1_ = EX(CS[2 * (J) + 1]); PNK[(J) & 3] = cvtpk(e0_, e1_); PIN(PNK); } } while (0)
#define S_PV(OB, PC0, PC1, PC2, PC3, PNA, PNB, CS) do { SBAR(); \
        S_PVG(0, OB, PC0, PNA, CS); S_PVG(1, OB, PC0, PNA, CS); SBAR(); S_PVG(2, OB, PC1, PNA, CS); S_PVG(3, OB, PC1, PNA, CS); SBAR(); \
        S_PVG(4, OB, PC2, PNB, CS); S_PVG(5, OB, PC2, PNB, CS); SBAR(); S_PVG(6, OB, PC3, PNB, CS); S_PVG(7, OB, PC3, PNB, CS); SBAR(); \
        } while (0)
#define S_H1(t, PC0, PC1, PC2, PC3) do { S_LK(t); S_QK(PC0, PC1, PC2, PC3); S_LV((t) - 1, 0); if ((t) >= tb0 && (t) < tb1) BAND_ADD(t); SBAR(); } while (0)
#define S_H2(t, PC0, PC1, PC2, PC3, PN0, PN1, PN2, PN3) do { S_PV(0, PC0, PC1, PC2, PC3, PN0, PN1, C0); S_LV((t) - 1, 2); S_PV(2, PC0, PC1, PC2, PC3, PN2, PN3, C1); \
        if ((t) == tb0 && tb0 > 0) { l_reg *= fscale; _Pragma("unroll") for (int d_ = 0; d_ < 4; ++d_) _Pragma("unroll") for (int r = 0; r < 16; ++r) o[d_][r] *= fscale; } SBAR(); } while (0)
#define S_END(tau) do { const bool gk_ = (tau) + 2 < NT, gv_ = (tau) + 1 < NT; \
        if (gk_) SDMA_KQ(((tau) + 2) % S_NK); if (gv_) SDMA_VQ(((tau) + 1) % S_NV); \
        if (gk_) { WAIT_BAR(4); } else if (gv_) { WAIT_BAR(2); } else { WAIT_BAR(0); } } while (0)
    WAIT_BAR(8);
    S_LK(0);
#pragma unroll
    for (int d0 = 0; d0 < 4; ++d0) {
        if (d0 == 0) { C0 = __builtin_amdgcn_mfma_f32_32x32x16_bf16(F[0], qr[0], zero16, 0, 0, 0); C1 = __builtin_amdgcn_mfma_f32_32x32x16_bf16(F[1], qr[0], zero16, 0, 0, 0); }
        else { C0 = __builtin_amdgcn_mfma_f32_32x32x16_bf16(F[2 * d0], qr[d0], C0, 0, 0, 0); C1 = __builtin_amdgcn_mfma_f32_32x32x16_bf16(F[2 * d0 + 1], qr[d0], C1, 0, 0, 0); } }
    if (0 >= tb0 && 0 < tb1) BAND_ADD(0);
    {
#pragma unroll
      for (int r = 0; r < 16; ++r) { C0[r] = EX(C0[r]); C1[r] = EX(C1[r]); }
      pa0 = (u32x4){cvtpk(C0[0], C0[1]), cvtpk(C0[2], C0[3]), cvtpk(C0[4], C0[5]), cvtpk(C0[6], C0[7])}; pa1 = (u32x4){cvtpk(C0[8], C0[9]), cvtpk(C0[10], C0[11]), cvtpk(C0[12], C0[13]), cvtpk(C0[14], C0[15])};
      pa2 = (u32x4){cvtpk(C1[0], C1[1]), cvtpk(C1[2], C1[3]), cvtpk(C1[4], C1[5]), cvtpk(C1[6], C1[7])}; pa3 = (u32x4){cvtpk(C1[8], C1[9]), cvtpk(C1[10], C1[11]), cvtpk(C1[12], C1[13]), cvtpk(C1[14], C1[15])}; }
    WAIT_BAR(4);
    if (c == 0) {
        int t = 1;
#pragma unroll 1
        for (; t + 1 < NT; t += 2) {
            S_H1(t, pa0, pa1, pa2, pa3);     S_H2(t, pa0, pa1, pa2, pa3, pb0, pb1, pb2, pb3);         S_END(t);
            S_H1(t + 1, pb0, pb1, pb2, pb3); S_H2(t + 1, pb0, pb1, pb2, pb3, pa0, pa1, pa2, pa3);     S_END(t + 1);
        }
        S_H1(t, pa0, pa1, pa2, pa3); S_H2(t, pa0, pa1, pa2, pa3, pb0, pb1, pb2, pb3); S_END(t);
    } else {
        S_H1(1, pa0, pa1, pa2, pa3); S_END(1);
        int t = 2;
#pragma unroll 1
        for (; t + 1 < NT; t += 2) {
            S_H2(t - 1, pa0, pa1, pa2, pa3, pb0, pb1, pb2, pb3); S_H1(t, pb0, pb1, pb2, pb3);         S_END(t);
            S_H2(t, pb0, pb1, pb2, pb3, pa0, pa1, pa2, pa3);     S_H1(t + 1, pa0, pa1, pa2, pa3);     S_END(t + 1);
        }
        S_H2(NT - 1, pa0, pa1, pa2, pa3, pb0, pb1, pb2, pb3);
    }
    { float sacc = 0.f;
#pragma unroll
      for (int i_ = 0; i_ < 4; ++i_) { DOT2(pb0[i_]); DOT2(pb1[i_]); DOT2(pb2[i_]); DOT2(pb3[i_]); }
      l_reg += sacc;
      S_LV(NT - 1, 0);
#pragma unroll
      for (int j = 0; j < 8; ++j) { const u32x4 pw_ = (j >> 1) == 0 ? pb0 : (j >> 1) == 1 ? pb1 : (j >> 1) == 2 ? pb2 : pb3; o[j & 1] = __builtin_amdgcn_mfma_f32_32x32x16_bf16(__builtin_bit_cast(bf16x8, pw_), F[j], o[j & 1], 0, 0, 0); }
      S_LV(NT - 1, 2);
#pragma unroll
      for (int j = 0; j < 8; ++j) { const u32x4 pw_ = (j >> 1) == 0 ? pb0 : (j >> 1) == 1 ? pb1 : (j >> 1) == 2 ? pb2 : pb3; o[2 + (j & 1)] = __builtin_amdgcn_mfma_f32_32x32x16_bf16(__builtin_bit_cast(bf16x8, pw_), F[j], o[2 + (j & 1)], 0, 0, 0); } }
#undef S_END
#undef S_H1
#undef S_H2
#undef S_PV
#undef S_PVG
#undef S_QK
#undef S_LV
#undef S_LK
#undef BAND_ADD
#undef DOT2
#undef PIN
#undef EX
#undef SDMA_K
#undef SDMA_V
#undef SDMA_KQ
#undef SDMA_VQ
    {
    const int lane = lane_id_v(), r32 = lane & 31, hi = lane >> 5;
    const float lam = expf(wave_sum(lamp[lane] * lamp[64 + lane])) - expf(wave_sum(lamp[128 + lane] * lamp[192 + lane])) + 0.2f;
    { auto rr = __builtin_amdgcn_permlane32_swap(__float_as_uint(l_reg), __float_as_uint(l_reg), false, false); l_reg = __uint_as_float(rr[0]) + __uint_as_float(rr[1]); }
    if (hi == 0) wsf[r32] = l_reg;
    asm volatile("s_waitcnt lgkmcnt(0)" ::: "memory");
    float rli[16];
#pragma unroll
    for (int r = 0; r < 16; ++r) rli[r] = (c == 0 ? 1.0f : lam) / wsf[crow(r, hi)];
    asm volatile("s_waitcnt lgkmcnt(0)\n\ts_barrier" ::: "memory");
    const lds_fptr stg = (lds_fptr)(shm + qi * D_STG);
    if (c == 1) {
#pragma unroll
        for (int d0 = 0; d0 < 4; ++d0)
#pragma unroll
            for (int r = 0; r < 16; ++r) stg[(d0 * 16 + r) * 64 + lane] = o[d0][r] * rli[r];
    }
    asm volatile("s_waitcnt lgkmcnt(0)\n\ts_barrier" ::: "memory");
    if (c == 0) {
#pragma unroll
        for (int d0 = 0; d0 < 4; ++d0)
#pragma unroll
            for (int r = 0; r < 16; ++r) o[d0][r] = o[d0][r] * rli[r] - stg[(d0 * 16 + r) * 64 + lane];
        asm volatile("s_waitcnt lgkmcnt(0)" ::: "memory");
#pragma unroll
        for (int d0 = 0; d0 < 4; ++d0)
#pragma unroll
            for (int r = 0; r < 16; ++r) stg[crow(r, hi) * 132 + d0 * 32 + r32] = o[d0][r];
        asm volatile("s_waitcnt lgkmcnt(0)" ::: "memory");
        const int row = lane >> 1, half = lane & 1;
        f32x4 v[16]; float ss = 0.f;
#pragma unroll
        for (int i = 0; i < 16; ++i) { v[i] = *(const __attribute__((address_space(3))) f32x4*)(stg + row * 132 + half * 64 + 4 * i); ss += (v[i][0] * v[i][0] + v[i][1] * v[i][1]) + (v[i][2] * v[i][2] + v[i][3] * v[i][3]); }
        ss = xadd<1>(ss);
        const float rn = 1.0f / sqrtf(ss * (1.0f / 128.0f) + EPS);
        bf16_t* Ow = O + (rowbase + q0 + row) * DM + h * 128 + half * 64;
#pragma unroll
        for (int i = 0; i < 8; ++i) { const f32x4 a = v[2 * i] * rn, bq = v[2 * i + 1] * rn;
            u32x4 w = {cvtpk(a[0], a[1]), cvtpk(a[2], a[3]), cvtpk(bq[0], bq[1]), cvtpk(bq[2], bq[3])};
            *(u32x4*)(Ow + 8 * i) = w; }
    }
    }
    asm volatile("s_waitcnt vmcnt(0) lgkmcnt(0)\n\ts_barrier" ::: "memory");
}
constexpr int N_SLOT = 16384, N_NSLOT = 3;
template <int HALF>
__device__ __forceinline__ void n_tile(f32x16 (&o)[2], float& l_reg, const bf16x8 (&qr)[4], lds_cptr kp, lds_cptr vp, lds_fptr tbl, int tb  , int cs, int hi) {
    f32x16 b0, b1;
#pragma unroll
    for (int rr = 0; rr < 16; ++rr) { const int k0 = crow(rr, hi), k1 = k0 + 32;
        const bool live0 = HALF == 0 || rr >= 12, live1 = HALF == 1 || rr < 4;
        if (live0) { const bool v = (unsigned)(k0 - cs) < 16u; const float x = tbl[v ? tb + k0 : 0]; b0[rr] = v ? x : -1e30f; } else b0[rr] = -1e30f;
        if (live1) { const bool v = (unsigned)(k1 - cs) < 16u; const float x = tbl[v ? tb + k1 : 0]; b1[rr] = v ? x : -1e30f; } else b1[rr] = -1e30f; }
    f32x16 p0, p1;
#pragma unroll
    for (int d0 = 0; d0 < 4; ++d0) {
        const bf16x8 k0 = *(const __attribute__((address_space(3))) bf16x8*)(kp + d0 * 2048);
        const bf16x8 k1 = *(const __attribute__((address_space(3))) bf16x8*)(kp + d0 * 2048 + 512);
        if (d0 == 0) { p0 = __builtin_amdgcn_mfma_f32_32x32x16_bf16(k0, qr[0], b0, 0, 0, 0); p1 = __builtin_amdgcn_mfma_f32_32x32x16_bf16(k1, qr[0], b1, 0, 0, 0); }
        else { p0 = __builtin_amdgcn_mfma_f32_32x32x16_bf16(k0, qr[d0], p0, 0, 0, 0); p1 = __builtin_amdgcn_mfma_f32_32x32x16_bf16(k1, qr[d0], p1, 0, 0, 0); }
    }
    float s = 0.f;
#pragma unroll
    for (int rr = 0; rr < 16; ++rr) {
        if (HALF == 0 || rr >= 12) { p0[rr] = __builtin_amdgcn_exp2f(p0[rr]); s += p0[rr]; } else p0[rr] = 0.f;
        if (HALF == 1 || rr < 4) { p1[rr] = __builtin_amdgcn_exp2f(p1[rr]); s += p1[rr]; } else p1[rr] = 0.f; }
    l_reg += s;
    u32x4 pw[4];
    pw[0] = (u32x4){cvtpk(p0[0], p0[1]), cvtpk(p0[2], p0[3]), cvtpk(p0[4], p0[5]), cvtpk(p0[6], p0[7])};
    pw[1] = (u32x4){cvtpk(p0[8], p0[9]), cvtpk(p0[10], p0[11]), cvtpk(p0[12], p0[13]), cvtpk(p0[14], p0[15])};
    pw[2] = (u32x4){cvtpk(p1[0], p1[1]), cvtpk(p1[2], p1[3]), cvtpk(p1[4], p1[5]), cvtpk(p1[6], p1[7])};
    pw[3] = (u32x4){cvtpk(p1[8], p1[9]), cvtpk(p1[10], p1[11]), cvtpk(p1[12], p1[13]), cvtpk(p1[14], p1[15])};
#pragma unroll
    for (int d0 = 0; d0 < 2; ++d0)
#pragma unroll
        for (int ks = (HALF == 0 ? 0 : 1); ks < (HALF == 0 ? 3 : 4); ++ks) {
            const s16x4 lo = vtr(vp + (d0 * 4 + ks) * 1024), hh = vtr(vp + (d0 * 4 + ks) * 1024 + 512);
            const bf16x8 vf = (bf16x8){lo[0], lo[1], lo[2], lo[3], hh[0], hh[1], hh[2], hh[3]};
            o[d0] = __builtin_amdgcn_mfma_f32_32x32x16_bf16(__builtin_bit_cast(bf16x8, pw[ks]), vf, o[d0], 0, 0, 0);
        }
}
template <int NPROBE = 0  >
__device__ __forceinline__ void n_unit(int b, int h, int rg, const bf16_t* Q, const bf16_t* K, const bf16_t* V, bf16_t* O, char* shm, char* aux, const int wave_in) {
    const int lane_ = lane_id_v();
    const int lane = lane_, r32 = lane & 31, hi = lane >> 5;
    const int wid = wave_in, half = wid & 1, r = 4 * rg + (wid >> 1);
    const long rowbase = (long)b * SEQ;
    const lds_fptr tbl = (lds_fptr)aux;
    const int c = 32 * half + r32;
    int rs = r - 4; rs = rs < 0 ? 0 : (rs > 56 ? 56 : rs);
    int cs = c - 8; cs = cs < 0 ? 0 : (cs > 48 ? 48 : cs);
    int kr_lo = 4 * rg - 4; kr_lo = kr_lo < 0 ? 0 : (kr_lo > 56 ? 56 : kr_lo);
    int kr_hi = 4 * rg + 3 - 4; kr_hi = (kr_hi < 0 ? 0 : (kr_hi > 56 ? 56 : kr_hi)) + 7;
    const int nt = kr_hi - kr_lo + 1;
    const unsigned lds0 = (unsigned)(uintptr_t)shm;
    const bf16_t* ksrc = K + (rowbase + kr_lo * 64 + lane) * DM + h * 64 + wid * 8;
    const bf16_t* vsrc = V + (rowbase + kr_lo * 64 + 16 * (wid & 3) + (lane >> 2)) * DM + h * 64 + (wid >> 2) * 32 + (lane & 3) * 8;
    const unsigned dst0 = lds0 + wid * 1024;
#define N_DMA(t, slot) do { const unsigned d_ = (unsigned)__builtin_amdgcn_readfirstlane(dst0 + (slot)); glds16(ksrc + (long)(t) * 64 * DM, d_); glds16(vsrc + (long)(t) * 64 * DM, d_ + 8192); } while (0)
    const bf16_t* Qw = Q + (rowbase + r * 64 + c) * DM + h * 64 + hi * 8;
    bf16x8 qr[4];
#pragma unroll
    for (int d0 = 0; d0 < 4; ++d0) qr[d0] = *(const bf16x8*)(Qw + d0 * 16);
    N_DMA(0, 0); N_DMA(1, N_SLOT);
    const lds_cptr shm3 = (lds_cptr)shm;
    const lds_cptr kp0 = shm3 + hi * 1024 + r32 * 16;
    const lds_cptr vp0 = shm3 + 8192 + ((lane >> 4) & 1) * 32 + (lane & 3) * 8 + (4 * hi + ((lane & 15) >> 2)) * 64;
    f32x16 o[2]; o[0] = f32x16{}; o[1] = f32x16{};
    float l_reg = 0.f;
    int slot = 0;
#pragma unroll 1
    for (int t = 0; t < nt; ++t) {
        if (t + 1 < nt) { WAIT_BAR(2); } else { WAIT_BAR(0); }
        if (t + 2 < nt) { int s2 = slot + 2 * N_SLOT; if (s2 >= N_NSLOT * N_SLOT) s2 -= N_NSLOT * N_SLOT; N_DMA(t + 2, s2); }
        const int kr = kr_lo + t;
        if (!(NPROBE & 1) && kr >= rs && kr < rs + 8) {
            const int tb = (kr - r + 7) * 31 - c + 15;
            if (half == 0) n_tile<0>(o, l_reg, qr, kp0 + slot, vp0 + slot, tbl, tb, cs, hi);
            else           n_tile<1>(o, l_reg, qr, kp0 + slot, vp0 + slot, tbl, tb, cs, hi);
        }
        slot += N_SLOT; if (slot >= N_NSLOT * N_SLOT) slot = 0;
    }
#undef N_DMA
    { auto rr = __builtin_amdgcn_permlane32_swap(__float_as_uint(l_reg), __float_as_uint(l_reg), false, false); l_reg = __uint_as_float(rr[0]) + __uint_as_float(rr[1]); }
    asm volatile("s_waitcnt lgkmcnt(0)\n\ts_barrier" ::: "memory");
    const lds_fptr wsf = (lds_fptr)(shm + wid * 8192);
    if (hi == 0) wsf[r32] = l_reg;
    asm volatile("s_waitcnt lgkmcnt(0)" ::: "memory");
    float rli[16];
#pragma unroll
    for (int rr = 0; rr < 16; ++rr) rli[rr] = 1.0f / wsf[crow(rr, hi)];
    asm volatile("s_waitcnt lgkmcnt(0)" ::: "memory");
    __attribute__((address_space(3))) unsigned short* stg = (__attribute__((address_space(3))) unsigned short*)(shm + wid * 8192 + 1024);
#pragma unroll
    for (int rr = 0; rr < 16; ++rr) { const int orow = crow(rr, hi);
#pragma unroll
        for (int d0 = 0; d0 < 2; ++d0) stg[orow * 64 + d0 * 32 + r32] = (unsigned short)(cvtpk(o[d0][rr] * rli[rr], 0.f) & 0xffffu); }
    asm volatile("s_waitcnt lgkmcnt(0)" ::: "memory");
    bf16_t* Ow = O + (rowbase + r * 64 + 32 * half) * DM + h * 64;
#pragma unroll
    for (int i = 0; i < 4; ++i) { const int row = i * 8 + (lane >> 3), ch = lane & 7;
        const u32x4 v = *(const __attribute__((address_space(3))) u32x4*)(stg + row * 64 + ch * 8);
        *(u32x4*)(Ow + (long)row * DM + ch * 8) = v; }
    asm volatile("s_waitcnt vmcnt(0) lgkmcnt(0)\n\ts_barrier" ::: "memory");
}
template <int NPROBE = 0>
__device__ __forceinline__ void n_unit8(int b, int h, int rg8, const bf16_t* Q, const bf16_t* K, const bf16_t* V, bf16_t* O, char* shm, char* aux, const int wave_in) {
    const int lane_ = lane_id_v();
    const int lane = lane_, r32 = lane & 31, hi = lane >> 5;
    const int wid = wave_in, r = 8 * rg8 + wid;
    const long rowbase = (long)b * SEQ;
    const lds_fptr tbl = (lds_fptr)aux;
    int rs = r - 4; rs = rs < 0 ? 0 : (rs > 56 ? 56 : rs);
    const int c0 = r32, c1 = 32 + r32;
    int cs0 = c0 - 8; cs0 = cs0 < 0 ? 0 : cs0;
    int cs1 = c1 - 8; cs1 = cs1 > 48 ? 48 : cs1;
    int kr_lo = 8 * rg8 - 4; kr_lo = kr_lo < 0 ? 0 : (kr_lo > 56 ? 56 : kr_lo);
    int kr_hi = 8 * rg8 + 7 - 4; kr_hi = (kr_hi < 0 ? 0 : (kr_hi > 56 ? 56 : kr_hi)) + 7;
    const int nt = kr_hi - kr_lo + 1;
    const unsigned lds0 = (unsigned)(uintptr_t)shm;
    const bf16_t* ksrc = K + (rowbase + kr_lo * 64 + lane) * DM + h * 64 + wid * 8;
    const bf16_t* vsrc = V + (rowbase + kr_lo * 64 + 16 * (wid & 3) + (lane >> 2)) * DM + h * 64 + (wid >> 2) * 32 + (lane & 3) * 8;
    const unsigned dst0 = lds0 + wid * 1024;
#define N_DMA(t, slot) do { const unsigned d_ = (unsigned)__builtin_amdgcn_readfirstlane(dst0 + (slot)); glds16(ksrc + (long)(t) * 64 * DM, d_); glds16(vsrc + (long)(t) * 64 * DM, d_ + 8192); } while (0)
    const bf16_t* Qw = Q + (rowbase + r * 64 + r32) * DM + h * 64 + hi * 8;
    bf16x8 qa[4], qb[4];
#pragma unroll
    for (int d0 = 0; d0 < 4; ++d0) { qa[d0] = *(const bf16x8*)(Qw + d0 * 16); qb[d0] = *(const bf16x8*)(Qw + 32 * DM + d0 * 16); }
    N_DMA(0, 0); N_DMA(1, N_SLOT);
    const lds_cptr shm3 = (lds_cptr)shm;
    const lds_cptr kp0 = shm3 + hi * 1024 + r32 * 16;
    const lds_cptr vp0 = shm3 + 8192 + ((lane >> 4) & 1) * 32 + (lane & 3) * 8 + (4 * hi + ((lane & 15) >> 2)) * 64;
    f32x16 oa[2], ob[2]; oa[0] = f32x16{}; oa[1] = f32x16{}; ob[0] = f32x16{}; ob[1] = f32x16{};
    float la = 0.f, lb = 0.f;
    int slot = 0;
#pragma unroll 1
    for (int t = 0; t < nt; ++t) {
        if (t + 1 < nt) { WAIT_BAR(2); } else { WAIT_BAR(0); }
        if (t + 2 < nt) { int s2 = slot + 2 * N_SLOT; if (s2 >= N_NSLOT * N_SLOT) s2 -= N_NSLOT * N_SLOT; N_DMA(t + 2, s2); }
        const int kr = kr_lo + t;
        if (!(NPROBE & 1) && kr >= rs && kr < rs + 8) {
            const int tbr = (kr - r + 7) * 31 + 15;
            n_tile<0>(oa, la, qa, kp0 + slot, vp0 + slot, tbl, tbr - c0, cs0, hi);
            n_tile<1>(ob, lb, qb, kp0 + slot, vp0 + slot, tbl, tbr - c1, cs1, hi);
        }
        slot += N_SLOT; if (slot >= N_NSLOT * N_SLOT) slot = 0;
    }
#undef N_DMA
    asm volatile("s_waitcnt lgkmcnt(0)\n\ts_barrier" ::: "memory");
    const lds_fptr wsf = (lds_fptr)(shm + wid * 8192);
    __attribute__((address_space(3))) unsigned short* stg = (__attribute__((address_space(3))) unsigned short*)(shm + wid * 8192 + 1024);
#pragma unroll
    for (int hf = 0; hf < 2; ++hf) {
        float l_reg = hf == 0 ? la : lb;
        { auto rr = __builtin_amdgcn_permlane32_swap(__float_as_uint(l_reg), __float_as_uint(l_reg), false, false); l_reg = __uint_as_float(rr[0]) + __uint_as_float(rr[1]); }
        if (hi == 0) wsf[r32] = l_reg;
        asm volatile("s_waitcnt lgkmcnt(0)" ::: "memory");
        float rli[16];
#pragma unroll
        for (int rr = 0; rr < 16; ++rr) rli[rr] = 1.0f / wsf[crow(rr, hi)];
        asm volatile("s_waitcnt lgkmcnt(0)" ::: "memory");
#pragma unroll
        for (int rr = 0; rr < 16; ++rr) { const int orow = crow(rr, hi);
#pragma unroll
            for (int d0 = 0; d0 < 2; ++d0) stg[orow * 64 + d0 * 32 + r32] = (unsigned short)(cvtpk((hf == 0 ? oa[d0][rr] : ob[d0][rr]) * rli[rr], 0.f) & 0xffffu); }
        asm volatile("s_waitcnt lgkmcnt(0)" ::: "memory");
        bf16_t* Ow = O + (rowbase + r * 64 + 32 * hf) * DM + h * 64;
#pragma unroll
        for (int i = 0; i < 4; ++i) { const int row = i * 8 + (lane >> 3), ch = lane & 7;
            const u32x4 v = *(const __attribute__((address_space(3))) u32x4*)(stg + row * 64 + ch * 8);
            *(u32x4*)(Ow + (long)row * DM + ch * 8) = v; }
        asm volatile("s_waitcnt lgkmcnt(0)" ::: "memory");
    }
    asm volatile("s_waitcnt vmcnt(0) lgkmcnt(0)\n\ts_barrier" ::: "memory");
}
#undef SBAR
#undef WAIT_BAR
}
#define GAS __attribute__((address_space(1)))
#define LAS __attribute__((address_space(3)))
typedef unsigned short bf16;
typedef unsigned v4u __attribute__((ext_vector_type(4)));
typedef float f32x4 __attribute__((ext_vector_type(4)));
typedef short bf16x8 __attribute__((ext_vector_type(8)));
typedef GAS unsigned gu32;
typedef GAS unsigned long long gu64;
#define RLX_AGENT __ATOMIC_RELAXED, __HIP_MEMORY_SCOPE_AGENT
#define LDS_WAIT() asm volatile("s_waitcnt lgkmcnt(0)" ::: "memory")
#define VM_WAIT() asm volatile("s_waitcnt vmcnt(0)" ::: "memory")
__device__ __forceinline__ unsigned long long rt() { return __builtin_amdgcn_s_memrealtime(); }
__device__ __forceinline__ unsigned f2bf(float f) { unsigned u = __builtin_bit_cast(unsigned, f); return (u + 0x7fffu + ((u >> 16) & 1u)) >> 16; }
__device__ __forceinline__ unsigned pk2(float lo, float hi) { return f2bf(lo) | (f2bf(hi) << 16); }

#define XB_TMO      128
#define XB_XCNT(j)  (256  + 64 * (j))
#define XB_XSUB(j)  (1280 + 64 * (j))
#define XB_XGEN(j)  (2304 + 64 * (j))
#define XB_TOP      3328
#define XB_TOPGEN   3392
#define XCD_BAR_WORDS 3456
#define XB_SPIN_CAP (1u << 18)

__device__ __forceinline__ unsigned xb_ld(unsigned* p)              { return __hip_atomic_load(p, __ATOMIC_RELAXED, __HIP_MEMORY_SCOPE_AGENT); }
__device__ __forceinline__ unsigned xb_add(unsigned* p, unsigned v) { return __hip_atomic_fetch_add(p, v, __ATOMIC_RELAXED, __HIP_MEMORY_SCOPE_AGENT); }
__device__ __forceinline__ unsigned xb_xcc_id() { return (unsigned)__builtin_amdgcn_s_getreg((3 << 11) | 20) & 0xFu; }
#define XB_SPIN(cond, bar) do { unsigned _sp = 0; while (cond) { __builtin_amdgcn_s_sleep(1); \
    if ((++_sp & 255u) == 0u) { if (xb_ld(&(bar)[XB_TMO])) break; if (_sp > XB_SPIN_CAP) { atomicAdd(&(bar)[XB_TMO], 1u); break; } } } } while (0)

struct XcdBarrier {
    unsigned* bar; unsigned x;
    volatile LAS unsigned* st;
};

__device__ __forceinline__ XcdBarrier xcd_barrier_post(unsigned* bar, volatile LAS unsigned* st, const bool leader) {
    XcdBarrier b; b.bar = bar; b.x = xb_xcc_id(); b.st = st;
    if (leader) (void)xb_add(&bar[XB_XCNT(b.x)], 1u);
    return b;
}
__device__ __forceinline__ void xcd_barrier_complete(unsigned* bar, unsigned x, unsigned& nloc, unsigned& nx) {
    const unsigned G = gridDim.x * gridDim.y * gridDim.z;
    unsigned sum, cnt, mine, sp = 0u;
    for (;;) {
        sum = 0u; cnt = 0u; mine = 0u;
#pragma unroll
        for (unsigned j = 0; j < 16; ++j) { const unsigned c = xb_ld(&bar[XB_XCNT(j)]); sum += c; cnt += (c > 0u) ? 1u : 0u; mine = (j == x) ? c : mine; }
        if (sum == G) break;
        __builtin_amdgcn_s_sleep(1);
        if ((++sp & 255u) == 0u) { if (xb_ld(&bar[XB_TMO])) break; if (sp > XB_SPIN_CAP) { atomicAdd(&bar[XB_TMO], 1u); break; } }
    }
    nloc = mine > 0u ? mine : 1u; nx = cnt > 0u ? cnt : 1u;
}

__device__ __forceinline__ void xcd_barrier(const XcdBarrier& b, const bool leader) {
    asm volatile("s_waitcnt vmcnt(0)" ::: "memory");
    __syncthreads();
    if (leader) {
        unsigned* bar = b.bar;
        __builtin_amdgcn_s_waitcnt(0);
        unsigned nloc = b.st[0], nx = b.st[1];
        if (nloc == 0u) { xcd_barrier_complete(bar, b.x, nloc, nx); b.st[0] = nloc; b.st[1] = nx; }
        const unsigned old = xb_add(&bar[XB_XSUB(b.x)], 1u);
        const unsigned gen = old / nloc;
        if (old + 1u == (gen + 1u) * nloc) {
            __builtin_amdgcn_fence(__ATOMIC_RELEASE, "agent");
            asm volatile("s_waitcnt vmcnt(0)" ::: "memory");
            const unsigned og = xb_add(&bar[XB_TOP], 1u);
            const unsigned tg = og / nx;
            if (og + 1u == (tg + 1u) * nx) xb_add(&bar[XB_TOPGEN], 1u);
            else XB_SPIN(xb_ld(&bar[XB_TOPGEN]) == tg, bar);
            __builtin_amdgcn_fence(__ATOMIC_ACQUIRE, "agent");
            xb_add(&bar[XB_XGEN(b.x)], 1u);
            asm volatile("s_waitcnt vmcnt(0)" ::: "memory");
        } else {
            XB_SPIN(xb_ld(&bar[XB_XGEN(b.x)]) == gen, bar);
            __builtin_amdgcn_fence(__ATOMIC_ACQUIRE, "agent");
            asm volatile("s_waitcnt vmcnt(0)" ::: "memory");
        }
    }
    __syncthreads();
}
constexpr int NWAVES = 8;
constexpr int BATCH = 4, SEQ = 4096, DMODEL = 1024, M = BATCH * SEQ, DFF = 2816, PLE = 256, DEPTH = 2;
constexpr size_t MiB = 1u << 20;
constexpr size_t WS_CTL = 0, CTL_ZERO_BYTES = 1 * MiB;
constexpr size_t SZ_WFI = (size_t)2 * DFF * DMODEL * 2, SZ_WFO = (size_t)DMODEL * DFF * 2, SZ_WQKV = (size_t)3 * DMODEL * DMODEL * 2, SZ_WSQ = (size_t)DMODEL * DMODEL * 2, SZ_WP = (size_t)DMODEL * PLE * 2;
constexpr size_t WS_WFI = 1 * MiB;
constexpr size_t WS_WFO = WS_WFI + 4 * SZ_WFI;
constexpr size_t WS_WQKV = WS_WFO + 4 * SZ_WFO;
constexpr size_t WS_WO = WS_WQKV + 2 * SZ_WQKV;
constexpr size_t WS_WG = WS_WO + 2 * SZ_WSQ;
constexpr size_t WS_WP = WS_WG + 2 * SZ_WSQ;
constexpr size_t WS_WEND = WS_WP + 2 * SZ_WP;
constexpr size_t SZ_ACT = (size_t)M * DMODEL * 2;
constexpr size_t WS_HBA = (WS_WEND + 4095) / 4096 * 4096;
constexpr size_t WS_OB = WS_HBA + SZ_ACT;
constexpr size_t WS_SSPA = WS_OB + SZ_ACT, WS_SSPB = WS_SSPA + (size_t)M * 64;
constexpr size_t WS_QKV = WS_SSPB + (size_t)M * 64;
constexpr size_t WS_HID = WS_QKV;
constexpr size_t WS_PB = WS_QKV + 3 * SZ_ACT;
constexpr size_t WS_PROJ = WS_PB + (size_t)2 * M * PLE * 2;
constexpr size_t WS_END = WS_PROJ + SZ_ACT;
static_assert((size_t)M * DFF * 2 <= 3 * SZ_ACT, "hid fits the Q|K|V region");
constexpr int CW_TMO = 0, CW_BAR = 4096;
constexpr int LDS_BYTES_ = 147456;
constexpr int RING_OFF = 0, RING_BYTES = 131072, LDSCTL_OFF = LDS_BYTES_ - 4096  , MISC_OFF = LDSCTL_OFF + 320, PT_OFF = LDSCTL_OFF + 512  , AUX_OFF = LDSCTL_OFF + 1024  , LDS_BYTES = 147456;
static_assert(8 * 16640 <= LDSCTL_OFF && LDS_BYTES == LDS_BYTES_ && AUX_OFF + 3072 <= LDS_BYTES && att::D_NSLOT * att::D_SLOT <= RING_BYTES && att::S_VBASE + att::S_NV * att::S_VSLOT <= RING_BYTES && 4 * att::D_STG <= RING_BYTES, "LDS map");

struct Args {
    const float* in[20]; float* out; unsigned char* ws;
    int ph_lo, ph_hi, li, x_in_out, hb_sel, pad;
};
struct Frame {
    LAS unsigned char* lds; volatile LAS unsigned* MISC; gu32* ctl;
    int tid, lane, wave, vcu, G;
};
__device__ __forceinline__ float wave_sum64(float v) { return wsum64(v); }
__device__ __forceinline__ const void* ldp(LAS unsigned char* lds, int k) {
    const unsigned long long v = *(volatile LAS unsigned long long*)(lds + PT_OFF + 8 * k);
    const unsigned lo = (unsigned)__builtin_amdgcn_readfirstlane((int)(unsigned)v), hi = (unsigned)__builtin_amdgcn_readfirstlane((int)(unsigned)(v >> 32));
    return (const void*)(const GAS char*)(uintptr_t)(((unsigned long long)hi << 32) | lo);
}
#define INP(k) ((const float*)ldp(F.lds, (k)))
template <int MAP> __device__ __forceinline__ int dest_row(int n0) {
    if (MAP == 1) { const int isu = n0 >= DFF, j0 = isu ? n0 - DFF : n0; return 256 * (j0 >> 7) + 128 * isu + (j0 & 127); }
    if (MAP == 2) { const int pn = n0 >> 8, rem = n0 & 255; return 256 * pn + 128 * ((rem & 63) >> 5) + 32 * (rem >> 6); }
    return n0;
}
template <int MAP> __device__ __forceinline__ void p0_matrix_np(const int gw, const int NGW, const int lane, const float* W, int K, int N, bf16* WT, const float* ksc, int kmask, float kmul, LAS float* scr) {
    const int nblk = N / 64, nitems = (K / 64) * nblk;
    const int lr = lane >> 4, lc = 4 * (lane & 15);
    for (int it = gw; it < nitems; it += NGW) {
        const int k0 = 64 * (it / nblk), n0 = 64 * (it % nblk);
        f32x4 v[16];
#pragma unroll
        for (int i = 0; i < 16; ++i) v[i] = __builtin_nontemporal_load((const GAS f32x4*)(W + (size_t)(k0 + 4 * i + lr) * N + n0 + lc));
#pragma unroll
        for (int i = 0; i < 16; ++i) { const int kk = 4 * i + lr; const float sc = ksc ? ksc[(k0 + kk) & kmask] * kmul : 1.0f;
            LAS float* d = scr + kk * 65 + lc; d[0] = v[i].x * sc; d[1] = v[i].y * sc; d[2] = v[i].z * sc; d[3] = v[i].w * sc; }
        LDS_WAIT(); asm volatile("" ::: "memory");
        const int c = lane & 7;
#pragma unroll
        for (int j = 0; j < 8; ++j) { const int n = (lane >> 3) + 8 * j; const LAS float* s = scr + (8 * c) * 65 + n;
            v4u o; o.x = pk2(s[0 * 65], s[1 * 65]); o.y = pk2(s[2 * 65], s[3 * 65]); o.z = pk2(s[4 * 65], s[5 * 65]); o.w = pk2(s[6 * 65], s[7 * 65]);
            *(GAS v4u*)(WT + (size_t)(dest_row<MAP>(n0 + (n & 32)) + (n & 31)) * K + k0 + 8 * c) = o; }
        LDS_WAIT(); asm volatile("" ::: "memory");
    }
}
template <int MAP> __device__ __forceinline__ void p0_matrix(const int gw, const int NGW, const int lane, const float* W, int K, int N, bf16* WT, const float* ksc, int kmask, float kmul, LAS float* scr) {
    const int nblk = N / 64, nitems = (K / 64) * nblk;
    const int lr = lane >> 4, lc = 4 * (lane & 15), c = lane & 7;
#define PM_LOAD(V, SC, IT) do { const int k0_ = 64 * ((IT) / nblk), n0_ = 64 * ((IT) % nblk); \
        _Pragma("unroll") for (int i = 0; i < 16; ++i) V[i] = __builtin_nontemporal_load((const GAS f32x4*)(W + (size_t)(k0_ + 4 * i + lr) * N + n0_ + lc)); \
        _Pragma("unroll") for (int i = 0; i < 16; ++i) SC[i] = ksc ? ksc[(k0_ + 4 * i + lr) & kmask] * kmul : 1.0f; } while (0)
#define PM_PROC(V, SC, IT) do { const int k0_ = 64 * ((IT) / nblk), n0_ = 64 * ((IT) % nblk); \
        _Pragma("unroll") for (int i = 0; i < 16; ++i) { LAS float* d = scr + (4 * i + lr) * 65 + lc; const float sc = SC[i]; d[0] = V[i].x * sc; d[1] = V[i].y * sc; d[2] = V[i].z * sc; d[3] = V[i].w * sc; } \
        LDS_WAIT(); asm volatile("" ::: "memory"); \
        _Pragma("unroll") for (int j = 0; j < 8; ++j) { const int n = (lane >> 3) + 8 * j; const LAS float* s_ = scr + (8 * c) * 65 + n; \
            v4u o; o.x = pk2(s_[0 * 65], s_[1 * 65]); o.y = pk2(s_[2 * 65], s_[3 * 65]); o.z = pk2(s_[4 * 65], s_[5 * 65]); o.w = pk2(s_[6 * 65], s_[7 * 65]); \
            *(GAS v4u*)(WT + (size_t)(dest_row<MAP>(n0_ + (n & 32)) + (n & 31)) * K + k0_ + 8 * c) = o; } \
        LDS_WAIT(); asm volatile("" ::: "memory"); } while (0)
    int it = gw; if (it >= nitems) return;
    f32x4 va[16], vb[16]; float sa[16], sb[16];
    PM_LOAD(va, sa, it);
    while (true) {
        const int it1 = it + NGW; if (it1 < nitems) PM_LOAD(vb, sb, it1);
        PM_PROC(va, sa, it);
        if (it1 >= nitems) break;
        const int it2 = it1 + NGW; if (it2 < nitems) PM_LOAD(va, sa, it2);
        PM_PROC(vb, sb, it1);
        if (it2 >= nitems) break;
        it = it2;
    }
#undef PM_LOAD
#undef PM_PROC
}
#ifndef MK_WGM_FFN
#define MK_WGM_FFN 4
#endif
#ifndef MK_WGM_QKV
#define MK_WGM_QKV 4
#endif
#ifndef MK_WGM_N1K
#define MK_WGM_N1K 4
#endif
#ifndef MK_ALIGN1
#define MK_ALIGN1 true
#endif
#ifndef MK_SP2
#define MK_SP2 true
#endif
#ifndef MK_CONV_PROBE
#define MK_CONV_PROBE 0
#endif
#ifndef MK_FILL
#define MK_FILL 1
#endif
#ifndef MK_REBAL
#define MK_REBAL 1
#endif
#ifndef MK_FILL_WAVES
#define MK_FILL_WAVES 4
#endif
#ifndef MK_CONV_PIPE
#define MK_CONV_PIPE 1
#endif
template <int MAP, int SET> __device__ __forceinline__ void pmx(const int gw, const int NGW, const int lane, const float* W, int K, int N, bf16* WT, const float* ksc, int kmask, float kmul, LAS float* scr) {
    if (MK_CONV_PIPE & (SET == 0 ? 1 : 2)) p0_matrix<MAP>(gw, NGW, lane, W, K, N, WT, ksc, kmask, kmul, scr); else p0_matrix_np<MAP>(gw, NGW, lane, W, K, N, WT, ksc, kmask, kmul, scr);
}
template <int SET> __device__ __forceinline__ void conv_weights(Frame& F, const int gw, const int NGW) {
    unsigned char* ws = (unsigned char*)ldp(F.lds, 21);
    LAS float* scr = (LAS float*)(F.lds + RING_OFF + F.wave * 16640);
    const float* ng = INP(2); const int lane = lane_id_v();
#define CV_WFI(i) pmx<1, SET>(gw, NGW, lane, INP(3) + (size_t)(i) * DMODEL * 2 * DFF, DMODEL, 2 * DFF, (bf16*)(ws + WS_WFI + (i) * SZ_WFI), ng + (((i) >> 1) * 4 + ((i) & 1) * 2) * DMODEL, 1023, 1.0f, scr)
#define CV_WFO(i) pmx<0, SET>(gw, NGW, lane, INP(4) + (size_t)(i) * DFF * DMODEL, DFF, DMODEL, (bf16*)(ws + WS_WFO + (i) * SZ_WFO), nullptr, 0, 1.0f, scr)
#define CV_WG(l)  pmx<0, SET>(gw, NGW, lane, INP(17) + (size_t)(l) * DMODEL * DMODEL, DMODEL, DMODEL, (bf16*)(ws + WS_WG + (l) * SZ_WSQ), ng + ((l) * 4 + 3) * DMODEL, 1023, 1.0f, scr)
#define CV_WP(l)  pmx<0, SET>(gw, NGW, lane, INP(19) + (size_t)(l) * PLE * DMODEL, PLE, DMODEL, (bf16*)(ws + WS_WP + (l) * SZ_WP), nullptr, 0, 1.0f, scr)
    if (SET == 0) { CV_WFI(0); CV_WP(0);
        if (MK_REBAL) { p0_matrix_np<1>(gw, NGW, lane, INP(3) + (size_t)1 * DMODEL * 2 * DFF, DMODEL, 2 * DFF, (bf16*)(ws + WS_WFI + 1 * SZ_WFI), ng + 2 * DMODEL, 1023, 1.0f, scr); p0_matrix_np<2>(gw, NGW, lane, INP(12), DMODEL, 3 * DMODEL, (bf16*)(ws + WS_WQKV + SZ_WQKV), ng + 5 * DMODEL, 1023, 1.0f, scr); }
    } else if (SET == 1) {
        CV_WFO(0);
        pmx<2, SET>(gw, NGW, lane, INP(6), DMODEL, 3 * DMODEL, (bf16*)(ws + WS_WQKV), ng + 1 * DMODEL, 1023, 1.0f, scr);
        pmx<0, SET>(gw, NGW, lane, INP(7), DMODEL, DMODEL, (bf16*)(ws + WS_WO), INP(11), 127, 0.8f, scr);
        if (!MK_REBAL) CV_WFI(1);
    } else if (SET == 2) { CV_WFO(1); CV_WG(0); CV_WFI(2);
    } else if (SET == 3) {
        CV_WFO(2);
        if (!MK_REBAL) pmx<2, SET>(gw, NGW, lane, INP(12), DMODEL, 3 * DMODEL, (bf16*)(ws + WS_WQKV + SZ_WQKV), ng + 5 * DMODEL, 1023, 1.0f, scr);
        pmx<0, SET>(gw, NGW, lane, INP(13), DMODEL, DMODEL, (bf16*)(ws + WS_WO + SZ_WSQ), nullptr, 0, 1.0f, scr);
        CV_WFI(3); CV_WP(1);
    } else { CV_WFO(3); CV_WG(1); }
#undef CV_WFI
#undef CV_WFO
#undef CV_WG
#undef CV_WP
}
__device__ __forceinline__ void conv_p(Frame& F, const int l, const int gw, const int NGW) {
    const size_t n4 = (size_t)M * PLE / 4; const GAS f32x4* p4 = (const GAS f32x4*)INP(1) + (size_t)l * n4; GAS unsigned long long* o8 = (GAS unsigned long long*)((unsigned char*)ldp(F.lds, 21) + WS_PB) + (size_t)l * n4;
    const int lane = lane_id_v();
    for (size_t i = (size_t)gw * 256 + lane; i < n4; i += (size_t)NGW * 256) { f32x4 v[4];
#pragma unroll
        for (int j = 0; j < 4; ++j) v[j] = __builtin_nontemporal_load(p4 + i + 64 * j);
#pragma unroll
        for (int j = 0; j < 4; ++j) o8[i + 64 * j] = (unsigned long long)pk2(v[j].x, v[j].y) | ((unsigned long long)pk2(v[j].z, v[j].w) << 32); }
}
__device__ __forceinline__ void p0_prologue(Frame& F, const Args& a) {
    unsigned char* ws = a.ws;
    const int gw = F.vcu * NWAVES + F.wave, NGW = F.G * NWAVES;
    const float* h0 = a.x_in_out ? a.out : a.in[0];
    bf16* hbB = (bf16*)(ws + (a.hb_sel ? WS_HBA : WS_OB)); float* sspB = (float*)(ws + (a.hb_sel ? WS_SSPA : WS_SSPB));
    for (int m = 2 * gw; m < M; m += 2 * NGW) {
        f32x4 v[2][4]; float s[2];
#pragma unroll
        for (int rr = 0; rr < 2; ++rr) { const GAS f32x4* xr = (const GAS f32x4*)(h0 + (size_t)(m + rr) * DMODEL) + F.lane;
#pragma unroll
            for (int j = 0; j < 4; ++j) v[rr][j] = __builtin_nontemporal_load(xr + 64 * j); }
#pragma unroll
        for (int rr = 0; rr < 2; ++rr) { float t = 0.f;
#pragma unroll
            for (int j = 0; j < 4; ++j) t += (v[rr][j].x * v[rr][j].x + v[rr][j].y * v[rr][j].y) + (v[rr][j].z * v[rr][j].z + v[rr][j].w * v[rr][j].w);
            s[rr] = wave_sum64(t);
            GAS unsigned long long* o8 = (GAS unsigned long long*)(hbB + (size_t)(m + rr) * DMODEL) + F.lane;
#pragma unroll
            for (int j = 0; j < 4; ++j) o8[64 * j] = (unsigned long long)pk2(v[rr][j].x, v[rr][j].y) | ((unsigned long long)pk2(v[rr][j].z, v[rr][j].w) << 32);
            if (F.lane < 16) sspB[(size_t)(m + rr) * 16 + F.lane] = F.lane == 0 ? s[rr] : 0.f; }
    }
    conv_p(F, 0, gw, NGW); if (!MK_FILL || MK_CONV_PROBE || MK_REBAL) conv_p(F, 1, gw, NGW);
    conv_weights<0>(F, gw, NGW);
    if (!MK_FILL || MK_CONV_PROBE) { conv_weights<1>(F, gw, NGW); conv_weights<2>(F, gw, NGW); conv_weights<3>(F, gw, NGW); conv_weights<4>(F, gw, NGW); }
}

#ifndef MK_KIND_MASK
#define MK_KIND_MASK 0x1ff
#endif
#ifndef MK_ATT_STAG
#define MK_ATT_STAG 0
#endif
#ifndef MK_NA_PROBE
#define MK_NA_PROBE 0
#endif
#ifndef MK_ATT_PROBE
#define MK_ATT_PROBE 0
#endif
#ifndef MK_ATT_SEL
#define MK_ATT_SEL 3
#endif
#ifndef MK_PLE_SEL
#define MK_PLE_SEL (MK_FILL ? 2 : 3)
#endif
#ifndef MK_REP
#define MK_REP 0
#endif
#define NREP(kind) ((((MK_REP) >> (kind)) & 1) ? 2 : 1)
#ifndef MK_REPNULL
#define MK_REPNULL 0
#endif
#define NNULL(kind) (((MK_REPNULL) >> (kind)) & 1)
struct Ctl { int lo, hi, li, x_in_out; };
#define IN(k) (C.lo <= (k) && (k) < C.hi)
#define INK(kind, k) ((((MK_KIND_MASK) >> (kind)) & 1) && IN(k))
#define SEAM(k) do { if (IN(k) && IN((k) + 1)) { int w_ = F.wave; asm volatile("" : "+s"(w_)); XcdBarrier b_; b_.bar = (unsigned*)(WSB + WS_CTL) + CW_BAR + C.li * XCD_BAR_WORDS; b_.x = xb_xcc_id(); b_.st = F.MISC + 8; \
        xcd_barrier(b_, w_ == 0 && lane_id_v() == 0); if (NREP(9) == 2) xcd_barrier(b_, w_ == 0 && lane_id_v() == 0); } } while (0)
#define WSB ((unsigned char*)ldp(F.lds, 21))
#define HOUT ((float*)ldp(F.lds, 20))
#define RING (F.lds + RING_OFF)
#define RSL ((LAS float*)(F.lds + RING_BYTES))
template <int l, int f> __device__ __forceinline__ void ph_ffn(Frame& F, const Ctl& C) {
    constexpr int pb = 1 + 8 * l, pf = pb + (f == 0 ? 0 : 5);
    if (INK(0, pf)) {
        unsigned char* ws = WSB;
        pg8::Gemm g{(bf16*)(ws + (f == 0 ? WS_OB : WS_HBA)), (bf16*)(ws + WS_WFI + (l * 2 + f) * SZ_WFI), M, 2 * DFF, DMODEL}; pg8::StaticOrder S; S.init(M, 2 * DFF, F.G, (int)blockIdx.x, MK_WGM_FFN);
        pg8::fill_rstd_table(RSL, (float*)(ws + (f == 0 ? WS_SSPB : WS_SSPA)), S, F.wave, lane_id_v(), 6); asm volatile("s_waitcnt lgkmcnt(0)" ::: "memory"); __syncthreads();
        pg8::EpiSwiGLU E{(bf16*)(ws + WS_HID), RSL};
        if (NNULL(0)) { pg8::EpiNull EN; pg8::gemm_phase<pg8::EpiNull, pg8::StaticOrder, true, MK_SP2>(RING, g, S, EN, F.wave); }
#pragma unroll 1
        for (int rep = 0; rep < NREP(0); ++rep) pg8::gemm_phase<pg8::EpiSwiGLU, pg8::StaticOrder, true, MK_SP2>(RING, g, S, E, F.wave);
        if (MK_FILL && (int)blockIdx.x >= 128) {
            const int c2 = (int)blockIdx.x - 128;
            if (l == 0 && f == 1 && !(MK_CONV_PROBE & 2) && !MK_REBAL) conv_p(F, 1, c2 * NWAVES + F.wave, 128 * NWAVES);
            if ((l == 0 && f == 0) || (l == 1 && f == 1)) {
                pg8::Gemm g2{(bf16*)(ws + WS_PB) + (size_t)l * M * PLE, (bf16*)(ws + WS_WP + l * SZ_WP), M, DMODEL, PLE}; pg8::PairOrder S2; S2.c2 = c2;
                pg8::EpiPlainBf16 E2{(bf16*)(ws + WS_PROJ), DMODEL};
                pg8::gemm_phase<pg8::EpiPlainBf16, pg8::PairOrder, true, MK_SP2>(RING, g2, S2, E2, F.wave); }
            if (l == 0 && f == 0 && !(MK_CONV_PROBE & (2 << 1))) { if (F.wave < MK_FILL_WAVES) conv_weights<1>(F, c2 * MK_FILL_WAVES + F.wave, 128 * MK_FILL_WAVES); }
            if (l == 0 && f == 1 && !(MK_CONV_PROBE & (2 << 2))) { if (F.wave < MK_FILL_WAVES) conv_weights<2>(F, c2 * MK_FILL_WAVES + F.wave, 128 * MK_FILL_WAVES); }
            if (l == 1 && f == 0 && !(MK_CONV_PROBE & (2 << 3))) { if (F.wave < MK_FILL_WAVES) conv_weights<3>(F, c2 * MK_FILL_WAVES + F.wave, 128 * MK_FILL_WAVES); }
            if (l == 1 && f == 1 && !(MK_CONV_PROBE & (2 << 4))) { if (F.wave < MK_FILL_WAVES) conv_weights<4>(F, c2 * MK_FILL_WAVES + F.wave, 128 * MK_FILL_WAVES); }
        }
    }
    SEAM(pf);
    if (INK(1, pf + 1)) {
        unsigned char* ws = WSB; float* hout = HOUT;
        pg8::Gemm g{(bf16*)(ws + WS_HID), (bf16*)(ws + WS_WFO + (l * 2 + f) * SZ_WFO), M, DMODEL, DFF}; pg8::StaticOrder S; S.init(M, DMODEL, F.G, (int)blockIdx.x, MK_WGM_N1K);
        if (NNULL(1)) { pg8::EpiNull EN; pg8::gemm_phase<pg8::EpiNull, pg8::StaticOrder, true, MK_SP2>(RING, g, S, EN, F.wave); }
#pragma unroll 1
        for (int rep = 0; rep < NREP(1); ++rep) {
        pg8::EpiResid E{(bf16*)(ws + (f == 0 ? WS_OB : WS_HBA)), (bf16*)(ws + WS_HBA), (float*)(ws + WS_SSPA), rep == NREP(1) - 1 ? 0.5f : 0.f};
        pg8::gemm_phase<pg8::EpiResid, pg8::StaticOrder, MK_ALIGN1, MK_SP2>(RING, g, S, E, F.wave); }
    }
    SEAM(pf + 1);
}
template <int l> __device__ __forceinline__ void ph_mixer(Frame& F, const Ctl& C, unsigned char* lds) {
    constexpr int pb = 1 + 8 * l;
    if (INK(2, pb + 2)) {
        unsigned char* ws = WSB;
        pg8::Gemm g{(bf16*)(ws + WS_HBA), (bf16*)(ws + WS_WQKV + l * SZ_WQKV), M, 3 * DMODEL, DMODEL}; pg8::StaticOrder S; S.init(M, 3 * DMODEL, F.G, (int)blockIdx.x, MK_WGM_QKV);
        pg8::fill_rstd_table(RSL, (float*)(ws + WS_SSPA), S, F.wave, lane_id_v(), 3); asm volatile("s_waitcnt lgkmcnt(0)" ::: "memory"); __syncthreads();
        pg8::EpiQKV E{(bf16*)(ws + WS_QKV), (size_t)M * DMODEL, RSL, INP(l == 0 ? 8 : 14), INP(l == 0 ? 9 : 15), 0.125f * 1.4426950408889634f};
        if (NNULL(2)) { pg8::EpiNull EN; pg8::gemm_phase<pg8::EpiNull, pg8::StaticOrder, true, MK_SP2>(RING, g, S, EN, F.wave); }
#pragma unroll 1
        for (int rep = 0; rep < NREP(2); ++rep) pg8::gemm_phase<pg8::EpiQKV, pg8::StaticOrder, true, MK_SP2>(RING, g, S, E, F.wave);
    }
    SEAM(pb + 2);
    if (INK(3, pb + 3)) {
        unsigned char* ws = WSB;
        bf16* QB = (bf16*)(ws + WS_QKV); bf16* KB = QB + (size_t)M * DMODEL; bf16* VB = KB + (size_t)M * DMODEL; bf16* OB = (bf16*)(ws + WS_OB);
        if (l == 0 && (MK_ATT_SEL & 1)) {
            const float* t5 = INP(5); const float* qg = INP(8); const float* kg = INP(9); const float* lamp = INP(10);
#pragma unroll 1
            for (int i = 0; i < 4 * NREP(3); ++i) { int vc_ = F.vcu; asm volatile("" : "+s"(vc_)); const int bh = (i & 3) * 8 + (vc_ >> 5), qb = vc_ & 31;
                if (MK_ATT_PROBE && NREP(3) == 2 && i < 4) att::d_unit<MK_ATT_PROBE>(bh >> 3, bh & 7, qb, QB, KB, VB, OB, t5, qg, kg, lamp, (char*)lds + RING_OFF, (char*)lds + AUX_OFF, F.wave);
                else if (MK_ATT_STAG) att::d_unit_s<0>(bh >> 3, bh & 7, qb, QB, KB, VB, OB, t5, qg, kg, lamp, (char*)lds + RING_OFF, (char*)lds + AUX_OFF, F.wave);
                else att::d_unit<0>(bh >> 3, bh & 7, qb, QB, KB, VB, OB, t5, qg, kg, lamp, (char*)lds + RING_OFF, (char*)lds + AUX_OFF, F.wave); }
        } else if (l == 1 && (MK_ATT_SEL & 2)) {
            const float* rpb = INP(16);
            int vc_ = F.vcu; asm volatile("" : "+s"(vc_));
#ifndef MK_NA8
#define MK_NA8 1
#endif
            const int h = MK_NA8 ? (vc_ >> 3) & 15 : vc_ >> 4, rg = MK_NA8 ? vc_ & 7 : vc_ & 15, bhi = vc_ >> 7;
            { const int tid_ = F.wave * 64 + lane_id_v(); LAS float* tb = (LAS float*)(F.lds + AUX_OFF);
              for (int i = tid_; i < 465; i += NWAVES * 64) tb[i] = rpb[h * 465 + i] * 1.4426950408889634f; }
            if (MK_NA8) {
#pragma unroll 1
                for (int i = 0; i < 2 * NREP(5); ++i)
                    { if (MK_NA_PROBE && NREP(5) == 2 && i < 2) att::n_unit8<MK_NA_PROBE>(2 * (i & 1) + bhi, h, rg, QB, KB, VB, OB, (char*)lds + RING_OFF, (char*)lds + AUX_OFF, F.wave);
                      else att::n_unit8<0>(2 * (i & 1) + bhi, h, rg, QB, KB, VB, OB, (char*)lds + RING_OFF, (char*)lds + AUX_OFF, F.wave); }
            } else {
#pragma unroll 1
                for (int i = 0; i < 4 * NREP(5); ++i)
                    { if (MK_NA_PROBE && NREP(5) == 2 && i < 4) att::n_unit<MK_NA_PROBE>(i & 3, h, rg, QB, KB, VB, OB, (char*)lds + RING_OFF, (char*)lds + AUX_OFF, F.wave);
                      else att::n_unit<0>(i & 3, h, rg, QB, KB, VB, OB, (char*)lds + RING_OFF, (char*)lds + AUX_OFF, F.wave); }
            }
        }
    }
    SEAM(pb + 3);
    if (INK(4, pb + 4)) {
        unsigned char* ws = WSB; float* hout = HOUT;
        pg8::Gemm g{(bf16*)(ws + WS_OB), (bf16*)(ws + WS_WO + l * SZ_WSQ), M, DMODEL, DMODEL}; pg8::StaticOrder S; S.init(M, DMODEL, F.G, (int)blockIdx.x, MK_WGM_N1K);
        if (NNULL(4)) { pg8::EpiNull EN; pg8::gemm_phase<pg8::EpiNull, pg8::StaticOrder, true, MK_SP2>(RING, g, S, EN, F.wave); }
#pragma unroll 1
        for (int rep = 0; rep < NREP(4); ++rep) {
        pg8::EpiResid E{(bf16*)(ws + WS_HBA), (bf16*)(ws + WS_HBA), (float*)(ws + WS_SSPA), rep == NREP(4) - 1 ? 1.0f : 0.f};
        pg8::gemm_phase<pg8::EpiResid, pg8::StaticOrder, MK_ALIGN1, MK_SP2>(RING, g, S, E, F.wave); }
    }
    SEAM(pb + 4);
}
template <int l> __device__ __forceinline__ void ph_ple(Frame& F, const Ctl& C) {
    constexpr int pb = 1 + 8 * l;
    if (INK(7, pb + 7)) {
        if (MK_PLE_SEL & 1) { unsigned char* ws = WSB;
          pg8::Gemm g{(bf16*)(ws + WS_PB) + (size_t)l * M * PLE, (bf16*)(ws + WS_WP + l * SZ_WP), M, DMODEL, PLE}; pg8::StaticOrder S; S.init(M, DMODEL, F.G, (int)blockIdx.x, MK_WGM_N1K);
          pg8::EpiPlainBf16 E{(bf16*)(ws + WS_PROJ), DMODEL};
#pragma unroll 1
          for (int rep = 0; rep < NREP(7); ++rep) pg8::gemm_phase<pg8::EpiPlainBf16, pg8::StaticOrder, true, MK_SP2>(RING, g, S, E, F.wave); }
        if (MK_PLE_SEL & 2) { unsigned char* ws = WSB; float* hout = HOUT;
          pg8::Gemm g{(bf16*)(ws + WS_HBA), (bf16*)(ws + WS_WG + l * SZ_WSQ), M, DMODEL, DMODEL}; pg8::StaticOrder S; S.init(M, DMODEL, F.G, (int)blockIdx.x, MK_WGM_N1K);
          pg8::fill_rstd_table(RSL, (float*)(ws + WS_SSPA), S, F.wave, lane_id_v(), 1); asm volatile("s_waitcnt lgkmcnt(0)" ::: "memory"); __syncthreads();
#pragma unroll 1
          for (int rep = 0; rep < NREP(7); ++rep) {
          pg8::EpiPLE E{(bf16*)(ws + WS_HBA), (bf16*)(ws + WS_OB), l == DEPTH - 1 ? hout : nullptr, RSL, (float*)(ws + WS_SSPB), INP(18) + l * DMODEL, (bf16*)(ws + WS_PROJ), rep == NREP(7) - 1 ? 1.0f : 0.f};
          pg8::gemm_phase<pg8::EpiPLE, pg8::StaticOrder, MK_ALIGN1, MK_SP2>(RING, g, S, E, F.wave); } }
    }
    SEAM(pb + 7);
}
__global__ void __launch_bounds__(NWAVES * 64, 2) mk_fwd(Args args) {
    extern __shared__ __attribute__((aligned(16))) unsigned char lds[];
    Frame F;
    F.lds = (LAS unsigned char*)lds; F.MISC = (volatile LAS unsigned*)(F.lds + MISC_OFF);
    F.tid = threadIdx.x; F.wave = __builtin_amdgcn_readfirstlane(F.tid >> 6); F.lane = lane_id_v();
    F.G = gridDim.x; { const int bx = blockIdx.x; F.vcu = (F.G % 8 == 0) ? (bx % 8) * (F.G / 8) + bx / 8 : bx; }
    F.ctl = (gu32*)(args.ws + WS_CTL);
    for (int u = F.tid; u < (LDS_BYTES - LDSCTL_OFF) / 4; u += NWAVES * 64) ((LAS unsigned*)(F.lds + LDSCTL_OFF))[u] = 0u;
    __syncthreads();
    if (F.tid == 0) {
#pragma unroll
        for (int k = 0; k < 20; ++k) *(LAS unsigned long long*)(F.lds + PT_OFF + 8 * k) = (unsigned long long)(uintptr_t)args.in[k];
        *(LAS unsigned long long*)(F.lds + PT_OFF + 8 * 20) = (unsigned long long)(uintptr_t)args.out; *(LAS unsigned long long*)(F.lds + PT_OFF + 8 * 21) = (unsigned long long)(uintptr_t)args.ws; }
    __syncthreads();
    (void)xcd_barrier_post((unsigned*)(F.ctl + CW_BAR) + args.li * XCD_BAR_WORDS, F.MISC + 8, F.tid == 0);
    Ctl C{args.ph_lo, args.ph_hi, args.li, args.x_in_out};
    if (INK(8, 0)) {
#pragma unroll 1
        for (int rep = 0; rep < NREP(8); ++rep) p0_prologue(F, args); }
    SEAM(0);
    ph_ffn<0, 0>(F, C); ph_mixer<0>(F, C, lds); ph_ffn<0, 1>(F, C); ph_ple<0>(F, C);
    ph_ffn<1, 0>(F, C); ph_mixer<1>(F, C, lds); ph_ffn<1, 1>(F, C); ph_ple<1>(F, C);
}
#undef IN
#undef INK
#undef SEAM
#undef WSB
#undef HOUT
#undef RING
#undef RSL
#ifndef MK_MODE
#define MK_MODE 0
#endif
#if MK_MODE == 2
namespace base {
constexpr int D = 1024, BATCH = 4, SEQ = 4096, M = BATCH * SEQ, DFF = 2816, PLE = 256;
constexpr float EPS = 1e-6f;

template <int TB>
__global__ __launch_bounds__(256) void k_gemm(const float* __restrict__ A, int lda, const float* __restrict__ B, int ldb, float* __restrict__ C, int ldc, int K) {
    __shared__ float As[16][68];
    __shared__ float Bs[16][68];
    const int tid = threadIdx.x, tx = tid & 15, ty = tid >> 4;
    const int m0 = blockIdx.y * 64, n0 = blockIdx.x * 64;
    float acc[4][4];
#pragma unroll
    for (int i = 0; i < 4; ++i)
#pragma unroll
        for (int j = 0; j < 4; ++j) acc[i][j] = 0.f;
    for (int k0 = 0; k0 < K; k0 += 16) {
        {
            const int r = tid >> 2, kk = (tid & 3) * 4;
            const float4 v = *(const float4*)(A + (size_t)(m0 + r) * lda + k0 + kk);
            As[kk + 0][r] = v.x; As[kk + 1][r] = v.y; As[kk + 2][r] = v.z; As[kk + 3][r] = v.w;
        }
        if (TB == 0) {
            const int kk = tid >> 4, nn = (tid & 15) * 4;
            const float4 v = *(const float4*)(B + (size_t)(k0 + kk) * ldb + n0 + nn);
            Bs[kk][nn + 0] = v.x; Bs[kk][nn + 1] = v.y; Bs[kk][nn + 2] = v.z; Bs[kk][nn + 3] = v.w;
        } else {
            const int nn = tid >> 2, kk = (tid & 3) * 4;
            const float4 v = *(const float4*)(B + (size_t)(n0 + nn) * ldb + k0 + kk);
            Bs[kk + 0][nn] = v.x; Bs[kk + 1][nn] = v.y; Bs[kk + 2][nn] = v.z; Bs[kk + 3][nn] = v.w;
        }
        __syncthreads();
#pragma unroll
        for (int kk = 0; kk < 16; ++kk) {
            float a[4], b[4];
#pragma unroll
            for (int i = 0; i < 4; ++i) a[i] = As[kk][ty * 4 + i];
#pragma unroll
            for (int j = 0; j < 4; ++j) b[j] = Bs[kk][tx * 4 + j];
#pragma unroll
            for (int i = 0; i < 4; ++i)
#pragma unroll
                for (int j = 0; j < 4; ++j) acc[i][j] = fmaf(a[i], b[j], acc[i][j]);
        }
        __syncthreads();
    }
#pragma unroll
    for (int i = 0; i < 4; ++i) {
        float4 v = {acc[i][0], acc[i][1], acc[i][2], acc[i][3]};
        *(float4*)(C + (size_t)(m0 + ty * 4 + i) * ldc + n0 + tx * 4) = v;
    }
}

__device__ __forceinline__ float wave_sum(float v) {
#pragma unroll
    for (int o = 1; o < 64; o <<= 1) v += __shfl_xor(v, o);
    return v;
}
__device__ __forceinline__ float wave_max(float v) {
#pragma unroll
    for (int o = 1; o < 64; o <<= 1) v = fmaxf(v, __shfl_xor(v, o));
    return v;
}

__global__ __launch_bounds__(256) void k_rmsnorm(const float* __restrict__ x, const float* __restrict__ gain, float* __restrict__ y, int rows) {
    const int lane = threadIdx.x & 63, row = blockIdx.x * 4 + (threadIdx.x >> 6);
    if (row >= rows) return;
    const float* xr = x + (size_t)row * D; float* yr = y + (size_t)row * D;
    float v[16]; float ss = 0.f;
#pragma unroll
    for (int j = 0; j < 16; ++j) { v[j] = xr[lane + 64 * j]; ss += v[j] * v[j]; }
    ss = wave_sum(ss);
    const float r = 1.0f / sqrtf(ss * (1.0f / D) + EPS);
#pragma unroll
    for (int j = 0; j < 16; ++j) yr[lane + 64 * j] = v[j] * r * gain[lane + 64 * j];
}
__global__ __launch_bounds__(256) void k_swiglu(const float* __restrict__ gu, float* __restrict__ hid, int rows) {
    const size_t n = (size_t)rows * DFF;
    for (size_t i = blockIdx.x * 256ull + threadIdx.x; i < n; i += gridDim.x * 256ull) {
        const size_t r = i / DFF, j = i % DFF;
        const float g = gu[r * (2 * DFF) + j], u = gu[r * (2 * DFF) + DFF + j];
        hid[i] = g / (1.0f + expf(-g)) * u;
    }
}
__global__ __launch_bounds__(256) void k_axpy(float* __restrict__ h, const float* __restrict__ y, float alpha, size_t n) {
    for (size_t i = blockIdx.x * 256ull + threadIdx.x; i < n; i += gridDim.x * 256ull) h[i] += alpha * y[i];
}
__global__ __launch_bounds__(256) void k_headnorm(float* __restrict__ x, int ld, int col0, int nheads, const float* __restrict__ gain, float scale, int rows) {
    const int lane = threadIdx.x & 63, row = blockIdx.x * 4 + (threadIdx.x >> 6);
    if (row >= rows) return;
    float* xr = x + (size_t)row * ld + col0;
    const float g = gain[lane] * scale;
    for (int h = 0; h < nheads; ++h) {
        const float v = xr[h * 64 + lane];
        const float ss = wave_sum(v * v);
        xr[h * 64 + lane] = v * (1.0f / sqrtf(ss * (1.0f / 64.0f) + EPS)) * g;
    }
}
__device__ __forceinline__ int t5_bucket(int rel) {
    const int n = rel < 0 ? -rel : rel;
    int b;
    if (n < 8) b = n;
    else { int l = 2 + (31 - __clz(n * n)); b = l < 15 ? l : 15; }
    return b + (rel > 0 ? 16 : 0);
}
__global__ __launch_bounds__(256) void k_softmax_diff(float* __restrict__ S0, const float* __restrict__ S1, const float* __restrict__ table, int head, const float* __restrict__ lamp) {
    __shared__ float red[8];
    __shared__ float tb[32];
    const int q = blockIdx.x, tid = threadIdx.x, lane = tid & 63, w = tid >> 6;
    if (tid < 32) tb[tid] = table[tid * 8 + head];
    float d01 = 0.f, d23 = 0.f;
    if (tid < 64) { d01 = lamp[tid] * lamp[64 + tid]; d23 = lamp[128 + tid] * lamp[192 + tid]; }
    __syncthreads();
    float* s0 = S0 + (size_t)q * SEQ; const float* s1 = S1 + (size_t)q * SEQ;
    float a[16], b[16];
    float m0 = -1e30f, m1 = -1e30f;
#pragma unroll
    for (int j = 0; j < 16; ++j) { const int k = tid + 256 * j; const float bi = tb[t5_bucket(k - q)]; a[j] = s0[k] + bi; b[j] = s1[k] + bi; m0 = fmaxf(m0, a[j]); m1 = fmaxf(m1, b[j]); }
    m0 = wave_max(m0); m1 = wave_max(m1);
    if (lane == 0) { red[w] = m0; red[4 + w] = m1; }
    __syncthreads();
    m0 = fmaxf(fmaxf(red[0], red[1]), fmaxf(red[2], red[3])); m1 = fmaxf(fmaxf(red[4], red[5]), fmaxf(red[6], red[7]));
    __syncthreads();
    float l0 = 0.f, l1 = 0.f;
#pragma unroll
    for (int j = 0; j < 16; ++j) { a[j] = expf(a[j] - m0); b[j] = expf(b[j] - m1); l0 += a[j]; l1 += b[j]; }
    l0 = wave_sum(l0); l1 = wave_sum(l1);
    if (lane == 0) { red[w] = l0; red[4 + w] = l1; }
    __syncthreads();
    l0 = (red[0] + red[1]) + (red[2] + red[3]); l1 = (red[4] + red[5]) + (red[6] + red[7]);
    __syncthreads();
    d01 = wave_sum(d01); d23 = wave_sum(d23);
    if (tid == 0) red[0] = expf(d01) - expf(d23) + 0.2f;
    __syncthreads();
    const float lam = red[0];
    const float i0 = 1.0f / l0, i1 = lam / l1;
#pragma unroll
    for (int j = 0; j < 16; ++j) s0[tid + 256 * j] = a[j] * i0 - b[j] * i1;
}
__global__ __launch_bounds__(256) void k_subln(float* __restrict__ o, const float* __restrict__ gain, int rows) {
    const int lane = threadIdx.x & 63, row = blockIdx.x * 4 + (threadIdx.x >> 6);
    if (row >= rows) return;
    float* orow = o + (size_t)row * D;
    for (int h = 0; h < 8; ++h) {
        const float v0 = orow[h * 128 + lane], v1 = orow[h * 128 + 64 + lane];
        const float ss = wave_sum(v0 * v0 + v1 * v1);
        const float r = (1.0f / sqrtf(ss * (1.0f / 128.0f) + EPS)) * 0.8f;
        orow[h * 128 + lane] = v0 * r * gain[lane]; orow[h * 128 + 64 + lane] = v1 * r * gain[64 + lane];
    }
}
__global__ __launch_bounds__(256) void k_na(const float* __restrict__ qkv, const float* __restrict__ rpb, float* __restrict__ out) {
    const int lane = threadIdx.x & 63, gw = blockIdx.x * 4 + (threadIdx.x >> 6);
    const int t = gw >> 4, h = gw & 15;
    if (t >= SEQ) return;
    const int r = t >> 6, c = t & 63;
    int rs = r - 4; rs = rs < 0 ? 0 : (rs > 56 ? 56 : rs);
    int cs = c - 8; cs = cs < 0 ? 0 : (cs > 48 ? 48 : cs);
    const float qd = qkv[(size_t)t * 3072 + h * 64 + lane];
    float m = -1e30f, l = 0.f, acc = 0.f;
    for (int i = 0; i < 8; ++i)
        for (int j = 0; j < 16; ++j) {
            const int kr = rs + i, kc = cs + j, kt = kr * 64 + kc;
            const float kd = qkv[(size_t)kt * 3072 + 1024 + h * 64 + lane];
            float s = wave_sum(qd * kd) + rpb[(h * 15 + (kr - r + 7)) * 31 + (kc - c + 15)];
            const float mn = fmaxf(m, s), f = expf(m - mn), p = expf(s - mn);
            const float vd = qkv[(size_t)kt * 3072 + 2048 + h * 64 + lane];
            l = l * f + p; acc = acc * f + p * vd; m = mn;
        }
    out[(size_t)t * D + h * 64 + lane] = acc / l;
}
__global__ __launch_bounds__(256) void k_ple(float* __restrict__ h, const float* __restrict__ g, const float* __restrict__ bias, const float* __restrict__ pr, size_t n) {
    for (size_t i = blockIdx.x * 256ull + threadIdx.x; i < n; i += gridDim.x * 256ull) {
        const float z = g[i] + bias[i & (D - 1)];
        h[i] += pr[i] / (1.0f + expf(-z));
    }
}

static void gemm(hipStream_t st, int TB, const float* A, int lda, const float* B, int ldb, float* C, int ldc, int Mr, int N, int K) {
    dim3 grid(N / 64, Mr / 64);
    if (TB == 0) hipLaunchKernelGGL(k_gemm<0>, grid, dim3(256), 0, st, A, lda, B, ldb, C, ldc, K);
    else         hipLaunchKernelGGL(k_gemm<1>, grid, dim3(256), 0, st, A, lda, B, ldb, C, ldc, K);
}
}
#endif
#ifndef MK_MODE
#define MK_MODE 0
#endif
#ifndef MK_OPT_MASK
#define MK_OPT_MASK 0xff
#endif
constexpr int N_PHASES = 1 + 8 * DEPTH;

#if MK_MODE == 2
namespace base {
struct Ctx { hipStream_t st; float *hn, *gu, *hid, *y, *qkv, *ob, *gg, *pr, *S0, *S1; void* const* d_in; float* h; };
static void ffn(const Ctx& c, int i, int f) {
    const float* ng = (const float*)c.d_in[2]; const float* w_in = (const float*)c.d_in[3]; const float* w_out = (const float*)c.d_in[4];
    const size_t R = SEQ;
    for (int b = 0; b < BATCH; ++b) { float* hb = c.h + (size_t)b * R * D;
        hipLaunchKernelGGL(k_rmsnorm, dim3(R / 4), dim3(256), 0, c.st, hb, ng + (i * 4 + (f == 0 ? 0 : 2)) * D, c.hn, (int)R);
        gemm(c.st, 0, c.hn, D, w_in + (size_t)(i * 2 + f) * D * 2 * DFF, 2 * DFF, c.gu, 2 * DFF, R, 2 * DFF, D);
        hipLaunchKernelGGL(k_swiglu, dim3(2048), dim3(256), 0, c.st, c.gu, c.hid, (int)R);
        gemm(c.st, 0, c.hid, DFF, w_out + (size_t)(i * 2 + f) * DFF * D, D, c.y, D, R, D, DFF);
        hipLaunchKernelGGL(k_axpy, dim3(2048), dim3(256), 0, c.st, hb, c.y, 0.5f, R * D); }
}
static void mixer(const Ctx& c, int i) {
    const float* ng = (const float*)c.d_in[2]; const size_t R = SEQ;
    for (int b = 0; b < BATCH; ++b) { float* hb = c.h + (size_t)b * R * D;
        hipLaunchKernelGGL(k_rmsnorm, dim3(R / 4), dim3(256), 0, c.st, hb, ng + (i * 4 + 1) * D, c.hn, (int)R);
        if (i == 0) {
            gemm(c.st, 0, c.hn, D, (const float*)c.d_in[6], 3 * D, c.qkv, 3 * D, R, 3 * D, D);
            hipLaunchKernelGGL(k_headnorm, dim3(R / 4), dim3(256), 0, c.st, c.qkv, 3 * D, 0, 16, (const float*)c.d_in[8], 0.125f, (int)R);
            hipLaunchKernelGGL(k_headnorm, dim3(R / 4), dim3(256), 0, c.st, c.qkv, 3 * D, D, 16, (const float*)c.d_in[9], 1.0f, (int)R);
            for (int hh = 0; hh < 8; ++hh) {
                gemm(c.st, 1, c.qkv + hh * 128, 3 * D, c.qkv + D + hh * 128, 3 * D, c.S0, SEQ, SEQ, SEQ, 64);
                gemm(c.st, 1, c.qkv + hh * 128 + 64, 3 * D, c.qkv + D + hh * 128 + 64, 3 * D, c.S1, SEQ, SEQ, SEQ, 64);
                hipLaunchKernelGGL(k_softmax_diff, dim3(SEQ), dim3(256), 0, c.st, c.S0, c.S1, (const float*)c.d_in[5], hh, (const float*)c.d_in[10]);
                gemm(c.st, 0, c.S0, SEQ, c.qkv + 2 * D + hh * 128, 3 * D, c.ob + hh * 128, D, SEQ, 128, SEQ); }
            hipLaunchKernelGGL(k_subln, dim3(R / 4), dim3(256), 0, c.st, c.ob, (const float*)c.d_in[11], (int)R);
            gemm(c.st, 0, c.ob, D, (const float*)c.d_in[7], D, c.y, D, R, D, D);
        } else {
            gemm(c.st, 0, c.hn, D, (const float*)c.d_in[12], 3 * D, c.qkv, 3 * D, R, 3 * D, D);
            hipLaunchKernelGGL(k_headnorm, dim3(R / 4), dim3(256), 0, c.st, c.qkv, 3 * D, 0, 16, (const float*)c.d_in[14], 0.125f, (int)R);
            hipLaunchKernelGGL(k_headnorm, dim3(R / 4), dim3(256), 0, c.st, c.qkv, 3 * D, D, 16, (const float*)c.d_in[15], 1.0f, (int)R);
            hipLaunchKernelGGL(k_na, dim3(SEQ * 16 / 4), dim3(256), 0, c.st, c.qkv, (const float*)c.d_in[16], c.ob);
            gemm(c.st, 0, c.ob, D, (const float*)c.d_in[13], D, c.y, D, R, D, D);
        }
        hipLaunchKernelGGL(k_axpy, dim3(2048), dim3(256), 0, c.st, hb, c.y, 1.0f, R * D); }
}
static void ple(const Ctx& c, int i) {
    const float* ng = (const float*)c.d_in[2]; const size_t R = SEQ; const float* p = (const float*)c.d_in[1];
    for (int b = 0; b < BATCH; ++b) { float* hb = c.h + (size_t)b * R * D;
        hipLaunchKernelGGL(k_rmsnorm, dim3(R / 4), dim3(256), 0, c.st, hb, ng + (i * 4 + 3) * D, c.hn, (int)R);
        gemm(c.st, 0, c.hn, D, (const float*)c.d_in[17] + (size_t)i * D * D, D, c.gg, D, R, D, D);
        gemm(c.st, 0, p + ((size_t)i * M + (size_t)b * R) * PLE, PLE, (const float*)c.d_in[19] + (size_t)i * PLE * D, D, c.pr, D, R, D, PLE);
        hipLaunchKernelGGL(k_ple, dim3(2048), dim3(256), 0, c.st, hb, c.gg, (const float*)c.d_in[18] + i * D, c.pr, R * D); }
}
}
#endif

extern "C" void kernel_launch(void* const* d_in, const int* in_sizes, int n_in, void* d_out, int out_size, void* d_ws, size_t ws_size, hipStream_t stream) {
    static int grid = 0;
    if (grid == 0) {
        if (n_in != 20 || in_sizes[0] != M * DMODEL || out_size != M * DMODEL || ws_size < WS_END) { fprintf(stderr, "kernel_launch: unexpected shapes / workspace (ws %zu, need %zu); nothing launched\n", ws_size, (size_t)WS_END); grid = -1; return; }
        int dev = 0, cus = 0;
        if (hipGetDevice(&dev) != hipSuccess || hipDeviceGetAttribute(&cus, hipDeviceAttributeMultiprocessorCount, dev) != hipSuccess) { grid = -1; return; }
        if (hipFuncSetAttribute((const void*)mk_fwd, hipFuncAttributeMaxDynamicSharedMemorySize, LDS_BYTES) != hipSuccess) { fprintf(stderr, "kernel_launch: hipFuncSetAttribute failed\n"); grid = -1; return; }
        int per_cu = 0; (void)hipOccupancyMaxActiveBlocksPerMultiprocessor(&per_cu, (const void*)mk_fwd, NWAVES * 64, LDS_BYTES); (void)hipGetLastError();
        grid = cus;
        if (grid != 256) fprintf(stderr, "kernel_launch: %d CUs; the unit maps assume 256\n", grid);
    }
    if (grid < 0) return;
    (void)hipMemsetAsync((char*)d_ws + WS_CTL, 0, CTL_ZERO_BYTES, stream);
    Args a{};
    for (int i = 0; i < 20; ++i) a.in[i] = (const float*)d_in[i];
    a.out = (float*)d_out; a.ws = (unsigned char*)d_ws;
#if MK_MODE == 0
    a.ph_lo = 0; a.ph_hi = N_PHASES; a.li = 0; a.x_in_out = 0; a.hb_sel = 0;
    hipLaunchKernelGGL(mk_fwd, dim3(grid), dim3(NWAVES * 64), LDS_BYTES, stream, a);
#elif MK_MODE == 1
    for (int ph = 0; ph < N_PHASES; ++ph) { a.ph_lo = ph; a.ph_hi = ph + 1; a.li = 0; a.x_in_out = 0; a.hb_sel = 0;
        hipLaunchKernelGGL(mk_fwd, dim3(grid), dim3(NWAVES * 64), LDS_BYTES, stream, a); }
#else
    {
        using namespace base;
        (void)hipMemcpyAsync(d_out, d_in[0], (size_t)M * DMODEL * sizeof(float), hipMemcpyDeviceToDevice, stream);
        float* wsf = (float*)((char*)d_ws + MiB); const size_t R = SEQ;
        Ctx c; c.st = stream; c.d_in = d_in; c.h = (float*)d_out;
        c.hn = wsf; c.gu = c.hn + R * D; c.hid = c.gu + R * 2 * base::DFF; c.y = c.hid + R * base::DFF; c.qkv = c.y + R * D; c.ob = c.qkv + R * 3 * D; c.gg = c.ob + R * D; c.pr = c.gg + R * D;
        c.S0 = c.gu; c.S1 = c.gu + (size_t)SEQ * SEQ;
        int li = 0;
        for (int sb = 0; sb < 8; ++sb) {
            const int l = sb >> 2, kind = sb & 3;
            if ((MK_OPT_MASK >> sb) & 1) {
                const int pb = 1 + 8 * l; int lo, hi;
                if (kind == 0) { lo = pb; hi = pb + 2; } else if (kind == 1) { lo = pb + 2; hi = pb + 5; } else if (kind == 2) { lo = pb + 5; hi = pb + 7; } else { lo = pb + 7; hi = pb + 8; }
                a.x_in_out = 1; a.hb_sel = kind == 0 ? 0 : 1;
                a.ph_lo = 0; a.ph_hi = 1; a.li = li++;
                hipLaunchKernelGGL(mk_fwd, dim3(grid), dim3(NWAVES * 64), LDS_BYTES, stream, a);
                a.ph_lo = lo; a.ph_hi = hi; a.li = li++;
                hipLaunchKernelGGL(mk_fwd, dim3(grid), dim3(NWAVES * 64), LDS_BYTES, stream, a);
            } else {
                if (kind == 0) ffn(c, l, 0); else if (kind == 1) mixer(c, l); else if (kind == 2) ffn(c, l, 1); else ple(c, l);
            }
        }
    }
#endif
}
```

```cpp
#define MK_MODE 0
#define MK_FILL_WAVES 3
#include <hip/hip_runtime.h>
#include <cstdio>
#include <cstdint>
template <int X> __device__ __forceinline__ float xadd(float v) {
    if constexpr (X == 32) { auto rr = __builtin_amdgcn_permlane32_swap(__float_as_uint(v), __float_as_uint(v), false, false); return __uint_as_float(rr[0]) + __uint_as_float(rr[1]); }
    else return v + __int_as_float(__builtin_amdgcn_ds_swizzle(__float_as_int(v), (X << 10) | 0x1f));
}
template <int X> __device__ __forceinline__ float xmax(float v) {
    if constexpr (X == 32) { auto rr = __builtin_amdgcn_permlane32_swap(__float_as_uint(v), __float_as_uint(v), false, false); return fmaxf(__uint_as_float(rr[0]), __uint_as_float(rr[1])); }
    else return fmaxf(v, __int_as_float(__builtin_amdgcn_ds_swizzle(__float_as_int(v), (X << 10) | 0x1f)));
}
__device__ __forceinline__ float wsum64(float v) { v = xadd<1>(v); v = xadd<2>(v); v = xadd<4>(v); v = xadd<8>(v); v = xadd<16>(v); return xadd<32>(v); }
__device__ __forceinline__ float wmax64(float v) { v = xmax<1>(v); v = xmax<2>(v); v = xmax<4>(v); v = xmax<8>(v); v = xmax<16>(v); return xmax<32>(v); }
__device__ __forceinline__ int lane_id_v() { int l; asm volatile("v_mbcnt_lo_u32_b32 %0, -1, 0\n\tv_mbcnt_hi_u32_b32 %0, -1, %0" : "=v"(l)); return l; }
namespace pg8 {
#define PG8_LAS __attribute__((address_space(3)))
typedef unsigned short bf16_t;
typedef short bf16x8 __attribute__((ext_vector_type(8)));
typedef float f32x4 __attribute__((ext_vector_type(4)));
typedef unsigned u32x4 __attribute__((ext_vector_type(4)));
constexpr int BM = 256, BK = 64, HALF = 128, HTB = HALF * BK * 2  , STAGE_BYTES = 8 * HTB, NXCD = 8;

__host__ __device__ __forceinline__ int lds_byte(int r, int c) { const int st = (r >> 4) * 2 + (c >> 5), rr = r & 15, cc = c & 31, ob = rr * 64 + cc * 2; return st * 1024 + (ob ^ (((ob >> 9) & 1) << 5)); }
__host__ __device__ __forceinline__ void stage_rc(int b, int& R, int& C) { const int st = b / 1024, sb = b % 1024, swz = sb ^ (((sb >> 9) & 1) << 5); R = (st >> 1) * 16 + swz / 64; C = (st & 1) * 32 + (swz % 64) / 2; }
__host__ __device__ __forceinline__ int perm32(int rho) { const int n = rho >> 4, i = rho & 15; return 8 * (i >> 2) + 4 * n + (i & 3); }

struct Unit { int pm, pn, idx; };
struct Gemm { const bf16_t* A; const bf16_t* Bt; int M, N, K; };

struct StaticOrder {
    int nM, nN, nwg, G, c, WGM;
    __host__ __device__ void init(int M, int N, int G_, int c_, int wgm = 8) { nM = M / BM; nN = N / BM; nwg = nM * nN; G = G_; c = c_; WGM = wgm; }
    __host__ __device__ bool next(int i, Unit& u) const {
        const long L = (long)i * G + c; if (L >= nwg) return false;
        int wgid = (int)L; { const int q = nwg / NXCD, r = nwg % NXCD, xcd = wgid % NXCD, off = wgid / NXCD; wgid = (xcd < r ? xcd * (q + 1) : r * (q + 1) + (xcd - r) * q) + off; }
        const int nig = WGM * nN, gid = wgid / nig, fm = gid * WGM, gsz = (nM - fm) < WGM ? (nM - fm) : WGM;
        u.pm = fm + ((wgid % nig) % gsz); u.pn = (wgid % nig) / gsz; u.idx = i; return true;
    }
    __device__ __forceinline__ void a_ready(const Unit&) const {}
    __device__ __forceinline__ void done(const Unit&) const {}
};

__device__ __forceinline__ unsigned cvt_pk_bf16(float lo, float hi) { unsigned r; asm volatile("v_cvt_pk_bf16_f32 %0, %1, %2" : "=v"(r) : "v"(lo), "v"(hi)); return r; }
typedef float f32x2 __attribute__((ext_vector_type(2)));
typedef unsigned u32x2 __attribute__((ext_vector_type(2)));
constexpr float RMS_EPS = 1e-6f, LOG2E = 1.4426950408889634f;
__device__ __forceinline__ float fast_sigmoid(float z) { return __builtin_amdgcn_rcpf(1.0f + __builtin_amdgcn_exp2f(-z * LOG2E)); }
__device__ __forceinline__ float bf2f(unsigned short b) { return __builtin_bit_cast(float, (unsigned)b << 16); }
__device__ __forceinline__ void row_rstd(float (&rs)[2][4], const float* ssp, int row0, int fq) {
#pragma unroll
    for (int ai = 0; ai < 2; ++ai)
#pragma unroll
        for (int m = 0; m < 4; ++m) {
            const f32x4 v = *(const f32x4*)(ssp + (size_t)(row0 + ai * HALF + m * 16) * 16 + 4 * fq);
            float s = (v[0] + v[1]) + (v[2] + v[3]); s = xadd<16>(s); s = xadd<32>(s);
            rs[ai][m] = __builtin_amdgcn_rsqf(s * (1.0f / 1024.0f) + RMS_EPS);
        }
}
__device__ __forceinline__ float row_rstd1(const float* ssp, int row, int fq) {
    const f32x4 v = *(const f32x4*)(ssp + (size_t)row * 16 + 4 * fq);
    float s = (v[0] + v[1]) + (v[2] + v[3]); s = xadd<16>(s); s = xadd<32>(s);
    return __builtin_amdgcn_rsqf(s * (1.0f / 1024.0f) + RMS_EPS);
}
#ifndef MK_WT_STORES
#define MK_WT_STORES 2
#endif
__device__ __forceinline__ void store16_wt(void* p, const u32x4 v) {
#if defined(MK_WT_STORES) && MK_WT_STORES == 1
    asm volatile("global_store_dwordx4 %0, %1, off sc1\n\ts_nop 1" :: "v"(p), "v"(v) : "memory");
#elif defined(MK_WT_STORES) && MK_WT_STORES == 2
    __builtin_nontemporal_store(v, (u32x4*)p);
#else
    *(u32x4*)p = v;
#endif
}
template <class Sched> __device__ __forceinline__ void fill_rstd_table(PG8_LAS float* rsl, const float* ssp, const Sched& S, int wave, int lane, int max_units) {
    for (int task = wave; task < max_units * 4; task += 8) { Unit u; const int i = task >> 2, q = task & 3;
        if (!S.next(i, u)) break;
        const int row = u.pm * BM + 64 * q + lane; const f32x4* sp = (const f32x4*)(ssp + (size_t)row * 16);
        const f32x4 a = sp[0], b = sp[1], c = sp[2], d = sp[3];
        const float s = (((a[0] + a[1]) + (a[2] + a[3])) + ((b[0] + b[1]) + (b[2] + b[3]))) + (((c[0] + c[1]) + (c[2] + c[3])) + ((d[0] + d[1]) + (d[2] + d[3])));
        rsl[i * 256 + 64 * q + lane] = __builtin_amdgcn_rsqf(s * (1.0f / 1024.0f) + RMS_EPS); }
}
__device__ __forceinline__ void row_rstd_lds(float (&rs)[2][4], const PG8_LAS float* rsl, const Unit& u, int wr, int fr) {
#pragma unroll
    for (int ai = 0; ai < 2; ++ai)
#pragma unroll
        for (int m = 0; m < 4; ++m) rs[ai][m] = rsl[u.idx * 256 + ai * HALF + wr * 64 + m * 16 + fr];
}
struct EpiSwiGLU {
    static constexpr bool PERM = true, AFTER_DRAIN = false;
    bf16_t* hid; const PG8_LAS float* rsl;
    __device__ __forceinline__ void operator()(const f32x4 (&acc)[2][2][4][2], const Unit& u, int wr, int wc, int fr, int fq) const {
        const int row0 = u.pm * BM + wr * 64 + fr, col0 = u.pn * HALF + wc * 32 + 8 * fq;
        float rs[2][4]; row_rstd_lds(rs, rsl, u, wr, fr);
#pragma unroll
        for (int ai = 0; ai < 2; ++ai)
#pragma unroll
            for (int m = 0; m < 4; ++m) { const float r = rs[ai][m]; float o[8]; const f32x2 nr2 = {-LOG2E * r, -LOG2E * r}, rr2 = {r * r, r * r}, one2 = {1.0f, 1.0f};
#pragma unroll
                for (int n = 0; n < 2; ++n)
#pragma unroll
                    for (int e = 0; e < 4; e += 2) {
                        const f32x2 g = {acc[ai][0][m][n][e], acc[ai][0][m][n][e + 1]}, uu = {acc[ai][1][m][n][e], acc[ai][1][m][n][e + 1]};
                        const f32x2 z = g * nr2; f32x2 d = {__builtin_amdgcn_exp2f(z[0]), __builtin_amdgcn_exp2f(z[1])}; d = d + one2;
                        const f32x2 s = {__builtin_amdgcn_rcpf(d[0]), __builtin_amdgcn_rcpf(d[1])};
                        const f32x2 p = ((g * uu) * rr2) * s; o[4 * n + e] = p[0]; o[4 * n + e + 1] = p[1]; }
                u32x4 w; w.x = cvt_pk_bf16(o[0], o[1]); w.y = cvt_pk_bf16(o[2], o[3]); w.z = cvt_pk_bf16(o[4], o[5]); w.w = cvt_pk_bf16(o[6], o[7]);
                store16_wt(hid + (size_t)(row0 + ai * HALF + m * 16) * 2816 + col0, w);
                if (m & 1) asm volatile("" ::: "memory"); }
    }
};
__device__ __forceinline__ void bf8_to_f32(const u32x4 w, f32x4& a, f32x4& b) {
    a[0] = __builtin_bit_cast(float, w.x << 16); a[1] = __builtin_bit_cast(float, w.x & 0xffff0000u); a[2] = __builtin_bit_cast(float, w.y << 16); a[3] = __builtin_bit_cast(float, w.y & 0xffff0000u);
    b[0] = __builtin_bit_cast(float, w.z << 16); b[1] = __builtin_bit_cast(float, w.z & 0xffff0000u); b[2] = __builtin_bit_cast(float, w.w << 16); b[3] = __builtin_bit_cast(float, w.w & 0xffff0000u);
}
struct EpiResid {
    static constexpr bool PERM = true, AFTER_DRAIN = false;
    const bf16_t* hin; bf16_t* hout; float* ssp; float alpha;
    __device__ __forceinline__ void operator()(const f32x4 (&acc)[2][2][4][2], const Unit& u, int wr, int wc, int fr, int fq) const {
        const int row0 = u.pm * BM + wr * 64 + fr, col0 = u.pn * BM + wc * 32 + 8 * fq;
        u32x4 hv[2][4][2]; float ssr[2][4];
#pragma unroll
        for (int ai = 0; ai < 2; ++ai)
#pragma unroll
            for (int m = 0; m < 4; ++m)
#pragma unroll
                for (int bj = 0; bj < 2; ++bj) hv[ai][m][bj] = *(const u32x4*)(hin + (size_t)(row0 + ai * HALF + m * 16) * 1024 + col0 + bj * HALF);
#pragma unroll
        for (int ai = 0; ai < 2; ++ai)
#pragma unroll
            for (int m = 0; m < 4; ++m) { const int row = row0 + ai * HALF + m * 16; f32x4 q = {0.f, 0.f, 0.f, 0.f};
#pragma unroll
                for (int bj = 0; bj < 2; ++bj) { f32x4 x0, x1; bf8_to_f32(hv[ai][m][bj], x0, x1);
                    x0 = x0 + acc[ai][bj][m][0] * alpha; x1 = x1 + acc[ai][bj][m][1] * alpha;
                    u32x4 w; w.x = cvt_pk_bf16(x0[0], x0[1]); w.y = cvt_pk_bf16(x0[2], x0[3]); w.z = cvt_pk_bf16(x1[0], x1[1]); w.w = cvt_pk_bf16(x1[2], x1[3]);
                    *(u32x4*)(hout + (size_t)row * 1024 + col0 + bj * HALF) = w;
                    q += x0 * x0; q += x1 * x1; }
                ssr[ai][m] = (q[0] + q[1]) + (q[2] + q[3]); }
#pragma unroll
        for (int ai = 0; ai < 2; ++ai)
#pragma unroll
            for (int m = 0; m < 4; ++m) ssr[ai][m] = xadd<16>(ssr[ai][m]);
#pragma unroll
        for (int ai = 0; ai < 2; ++ai)
#pragma unroll
            for (int m = 0; m < 4; ++m) { const float t = xadd<32>(ssr[ai][m]); if (fq == 0) ssp[(size_t)(row0 + ai * HALF + m * 16) * 16 + u.pn * 4 + wc] = t; }
    }
};
struct EpiQKV {
    static constexpr bool PERM = true, AFTER_DRAIN = false;
    bf16_t* Q; size_t kv_stride; const PG8_LAS float* rsl; const float* qg; const float* kg; float qscale;
    __device__ __forceinline__ void operator()(const f32x4 (&acc)[2][2][4][2], const Unit& u, int wr, int wc, int fr, int fq) const {
        const int row0 = u.pm * BM + wr * 64 + fr, kind = u.pn >> 2, hcol = (u.pn & 3) * 256 + wc * 64 + 8 * fq;
        float rs[2][4]; row_rstd_lds(rs, rsl, u, wr, fr);
        bf16_t* dst = Q + (size_t)kind * kv_stride;
        f32x4 gv[2][2];
#pragma unroll
        for (int bj = 0; bj < 2; ++bj)
#pragma unroll
            for (int n = 0; n < 2; ++n) gv[bj][n] = (f32x4){1.f, 1.f, 1.f, 1.f};
        if (kind < 2) { const float* g = qg + (kg - qg) * kind; const float sc = kind == 0 ? qscale : 1.0f;
#pragma unroll
            for (int bj = 0; bj < 2; ++bj)
#pragma unroll
                for (int n = 0; n < 2; ++n) gv[bj][n] = *(const f32x4*)(g + 32 * bj + 8 * fq + 4 * n) * sc; }
        float ss[2][4];
#pragma unroll
        for (int ai = 0; ai < 2; ++ai)
#pragma unroll
            for (int m = 0; m < 4; ++m) { f32x4 q = acc[ai][0][m][0] * acc[ai][0][m][0]; q += acc[ai][0][m][1] * acc[ai][0][m][1]; q += acc[ai][1][m][0] * acc[ai][1][m][0]; q += acc[ai][1][m][1] * acc[ai][1][m][1];
                ss[ai][m] = (q[0] + q[1]) + (q[2] + q[3]); }
#pragma unroll
        for (int ai = 0; ai < 2; ++ai)
#pragma unroll
            for (int m = 0; m < 4; ++m) ss[ai][m] = xadd<16>(ss[ai][m]);
#pragma unroll
        for (int ai = 0; ai < 2; ++ai)
#pragma unroll
            for (int m = 0; m < 4; ++m) ss[ai][m] = xadd<32>(ss[ai][m]);
#pragma unroll
        for (int ai = 0; ai < 2; ++ai)
#pragma unroll
            for (int m = 0; m < 4; ++m) { const float r = rs[ai][m];
                const float hr = kind < 2 ? __builtin_amdgcn_rsqf(ss[ai][m] * (r * r) * (1.0f / 64.0f) + RMS_EPS) : 1.0f; const float sc = r * hr;
                bf16_t* rowp = dst + (size_t)(row0 + ai * HALF + m * 16) * 1024 + hcol;
#pragma unroll
                for (int bj = 0; bj < 2; ++bj) { const f32x4 v0 = acc[ai][bj][m][0] * sc * gv[bj][0], v1 = acc[ai][bj][m][1] * sc * gv[bj][1];
                    u32x4 w; w.x = cvt_pk_bf16(v0[0], v0[1]); w.y = cvt_pk_bf16(v0[2], v0[3]); w.z = cvt_pk_bf16(v1[0], v1[1]); w.w = cvt_pk_bf16(v1[2], v1[3]);
                    *(u32x4*)(rowp + 32 * bj) = w; }
                asm volatile("" ::: "memory"); }
    }
};
struct EpiPlainBf16 {
    static constexpr bool PERM = true, AFTER_DRAIN = false;
    bf16_t* O; int ldc;
    __device__ __forceinline__ void operator()(const f32x4 (&acc)[2][2][4][2], const Unit& u, int wr, int wc, int fr, int fq) const {
        const int row0 = u.pm * BM + wr * 64 + fr, col0 = u.pn * BM + wc * 32 + 8 * fq;
#pragma unroll
        for (int ai = 0; ai < 2; ++ai)
#pragma unroll
            for (int m = 0; m < 4; ++m) { bf16_t* rowp = O + (size_t)(row0 + ai * HALF + m * 16) * ldc + col0;
#pragma unroll
                for (int bj = 0; bj < 2; ++bj) { const f32x4 v0 = acc[ai][bj][m][0], v1 = acc[ai][bj][m][1];
                    u32x4 w; w.x = cvt_pk_bf16(v0[0], v0[1]); w.y = cvt_pk_bf16(v0[2], v0[3]); w.z = cvt_pk_bf16(v1[0], v1[1]); w.w = cvt_pk_bf16(v1[2], v1[3]);
                    *(u32x4*)(rowp + bj * HALF) = w; } }
    }
};
struct EpiPLE {
    static constexpr bool PERM = true, AFTER_DRAIN = false;
    const bf16_t* hin; bf16_t* hbo; float* fout; const PG8_LAS float* rsl; float* sspo; const float* bgate; const bf16_t* proj; float scale;
    __device__ __forceinline__ void operator()(const f32x4 (&acc)[2][2][4][2], const Unit& u, int wr, int wc, int fr, int fq) const {
        const int row0 = u.pm * BM + wr * 64 + fr, col0 = u.pn * BM + wc * 32 + 8 * fq;
        float rs[2][4]; row_rstd_lds(rs, rsl, u, wr, fr);
        u32x4 hv[2][2], pv[2][2]; float ssr[8];
#define PLE_LOAD(Q) do { const size_t off_ = (size_t)(row0 + ((Q) >> 2) * HALF + ((Q) & 3) * 16) * 1024 + col0; \
            _Pragma("unroll") for (int bj = 0; bj < 2; ++bj) { hv[(Q) & 1][bj] = *(const u32x4*)(hin + off_ + bj * HALF); pv[(Q) & 1][bj] = *(const u32x4*)(proj + off_ + bj * HALF); } } while (0)
#define PLE_DO(Q) do { const int ai = (Q) >> 2, m = (Q) & 3; const int row = row0 + ai * HALF + m * 16; const float r = rs[ai][m]; f32x4 q = {0.f, 0.f, 0.f, 0.f}; \
            _Pragma("unroll") for (int bj = 0; bj < 2; ++bj) { const size_t o2 = (size_t)row * 1024 + col0 + bj * HALF; \
                f32x4 x[2], pj[2]; bf8_to_f32(hv[(Q) & 1][bj], x[0], x[1]); bf8_to_f32(pv[(Q) & 1][bj], pj[0], pj[1]); \
                _Pragma("unroll") for (int n = 0; n < 2; ++n) { const f32x4 z = (acc[ai][bj][m][n] * r + *(const f32x4*)(bgate + col0 + bj * HALF + 4 * n)) * (-LOG2E); \
                    f32x4 d = {__builtin_amdgcn_exp2f(z[0]), __builtin_amdgcn_exp2f(z[1]), __builtin_amdgcn_exp2f(z[2]), __builtin_amdgcn_exp2f(z[3])}; d = d + 1.0f; \
                    const f32x4 sg = {__builtin_amdgcn_rcpf(d[0]), __builtin_amdgcn_rcpf(d[1]), __builtin_amdgcn_rcpf(d[2]), __builtin_amdgcn_rcpf(d[3])}; \
                    x[n] = x[n] + sg * (pj[n] * scale); } \
                if (fout) { __builtin_nontemporal_store(x[0], (f32x4*)(fout + o2)); __builtin_nontemporal_store(x[1], (f32x4*)(fout + o2 + 4)); } \
                else { u32x4 w; w.x = cvt_pk_bf16(x[0][0], x[0][1]); w.y = cvt_pk_bf16(x[0][2], x[0][3]); w.z = cvt_pk_bf16(x[1][0], x[1][1]); w.w = cvt_pk_bf16(x[1][2], x[1][3]); *(u32x4*)(hbo + o2) = w; } \
                q += x[0] * x[0]; q += x[1] * x[1]; } \
            ssr[Q] = (q[0] + q[1]) + (q[2] + q[3]); asm volatile("" ::: "memory"); } while (0)
        PLE_LOAD(0); PLE_LOAD(1);
        PLE_DO(0); PLE_LOAD(2); PLE_DO(1); PLE_LOAD(3); PLE_DO(2); PLE_LOAD(4); PLE_DO(3); PLE_LOAD(5); PLE_DO(4); PLE_LOAD(6); PLE_DO(5); PLE_LOAD(7); PLE_DO(6); PLE_DO(7);
#undef PLE_LOAD
#undef PLE_DO
        if (!fout) {
#pragma unroll
            for (int Q = 0; Q < 8; ++Q) ssr[Q] = xadd<16>(ssr[Q]);
#pragma unroll
            for (int Q = 0; Q < 8; ++Q) { const float t = xadd<32>(ssr[Q]); if (fq == 0) sspo[(size_t)(row0 + (Q >> 2) * HALF + (Q & 3) * 16) * 16 + u.pn * 4 + wc] = t; } }
    }
};
struct EpiNull {
    static constexpr bool PERM = true, AFTER_DRAIN = false;
    __device__ __forceinline__ void operator()(const f32x4 (&acc)[2][2][4][2], const Unit&, int, int, int, int) const {
#pragma unroll
        for (int ai = 0; ai < 2; ++ai)
#pragma unroll
            for (int bj = 0; bj < 2; ++bj)
#pragma unroll
                for (int m = 0; m < 4; ++m)
#pragma unroll
                    for (int n = 0; n < 2; ++n) asm volatile("" :: "v"(acc[ai][bj][m][n]));
    }
};
struct PairOrder {
    int c2;
    __device__ __forceinline__ bool next(int i, Unit& u) const { if (i >= 2) return false; const int id = 2 * c2 + i; u.pm = id >> 2; u.pn = id & 3; u.idx = i; return true; }
    __device__ __forceinline__ void a_ready(const Unit&) const {}
    __device__ __forceinline__ void done(const Unit&) const {}
};
template <class Epi, class Sched, bool ALIGN_EPI = false, bool SP2 = false>
__device__ __forceinline__ void gemm_phase(PG8_LAS unsigned char* lds, const Gemm g, const Sched& S, const Epi& E, const int wave_in) {
    const int lane_ = lane_id_v();
    const int wid = wave_in, lane = lane_, tid = wid * 64 + lane, wr = wid >> 2, wc = wid & 3, fr = lane & 15, fq = lane >> 4;
    const int K = g.K, nt = K / BK;
    unsigned voffA[2], voffB[2];
#pragma unroll
    for (int i = 0; i < 2; ++i) { int R, C; stage_rc(tid * 16 + i * 8192, R, C); const int Rb = Epi::PERM ? ((R & ~31) + perm32(R & 31)) : R;
        voffA[i] = (unsigned)(R * K + C) * 2u; voffB[i] = (unsigned)(Rb * K + C) * 2u; }
    const size_t kstep = (size_t)(BK * 2);
    const size_t hstep = (size_t)HALF * K * 2;
    const size_t tstep = 2 * hstep;
    const unsigned ldsw = (unsigned)wid * 1024u;
    const int aoff = lds_byte(wr * 64 + fr, fq * 8), boff = lds_byte(wc * 32 + fr, fq * 8);
#define PG8_SA(b, h) (((b) * 2 + (h)) * HTB)
#define PG8_SB(b, h) ((4 + (b) * 2 + (h)) * HTB)
#define PG8_STAGE(bufoff, gbase, voff) do { _Pragma("unroll") for (int _i = 0; _i < 2; ++_i) \
        __builtin_amdgcn_global_load_lds((const unsigned*)((const char*)(gbase) + (voff)[_i]), (PG8_LAS unsigned*)(lds + (bufoff) + ldsw + _i * 8192), 16, 0, 0); } while (0)
#define PG8_LDA(dst, b, h) do { _Pragma("unroll") for (int m = 0; m < 4; ++m) _Pragma("unroll") for (int k = 0; k < 2; ++k) dst[m][k] = *(const PG8_LAS bf16x8*)(lds + PG8_SA(b, h) + aoff + m * 2048 + k * 1024); } while (0)
#define PG8_LDB(dst, b, h) do { _Pragma("unroll") for (int n = 0; n < 2; ++n) _Pragma("unroll") for (int k = 0; k < 2; ++k) dst[n][k] = *(const PG8_LAS bf16x8*)(lds + PG8_SB(b, h) + boff + n * 2048 + k * 1024); } while (0)
#define PG8_MMA(ai, bj, At, Bt) do { __builtin_amdgcn_s_setprio(1); _Pragma("unroll") for (int m = 0; m < 4; ++m) _Pragma("unroll") for (int n = 0; n < 2; ++n) _Pragma("unroll") for (int k = 0; k < 2; ++k) \
        acc[ai][bj][m][n] = __builtin_amdgcn_mfma_f32_16x16x32_bf16(Bt[n][k], At[m][k], acc[ai][bj][m][n], 0, 0, 0); __builtin_amdgcn_s_setprio(0); } while (0)
#define PG8_WAIT_V(n) asm volatile("s_waitcnt vmcnt(" #n ")" ::: "memory")
#define PG8_WAIT_L(n) asm volatile("s_waitcnt lgkmcnt(" #n ")" ::: "memory")
#define PG8_BAR __builtin_amdgcn_s_barrier()
#define PG8_SCHED __builtin_amdgcn_sched_barrier(0)
    Unit cur, nxt; int ui = 0;
    if (!S.next(0, cur)) return;
    f32x4 acc[2][2][4][2];
#pragma unroll
    for (int a = 0; a < 2; ++a)
#pragma unroll
        for (int b = 0; b < 2; ++b)
#pragma unroll
            for (int m = 0; m < 4; ++m)
#pragma unroll
                for (int n = 0; n < 2; ++n) acc[a][b][m][n] = (f32x4){0.f, 0.f, 0.f, 0.f};
    bf16x8 At[4][2], B0[2][2], B1[2][2];
    const char* cA = (const char*)g.A + (size_t)cur.pm * tstep; const char* cB = (const char*)g.Bt + (size_t)cur.pn * tstep;
    S.a_ready(cur);
    if constexpr (SP2) {
        PG8_STAGE(PG8_SB(0, 0), cB, voffB); PG8_STAGE(PG8_SB(0, 1), cB + hstep, voffB); PG8_STAGE(PG8_SA(0, 0), cA, voffA); PG8_STAGE(PG8_SA(0, 1), cA + hstep, voffA);
        if (wr == 1) PG8_BAR;
        PG8_WAIT_V(2); PG8_BAR;
        PG8_STAGE(PG8_SB(1, 0), cB + kstep, voffB); PG8_STAGE(PG8_SA(1, 0), cA + kstep, voffA); PG8_STAGE(PG8_SB(1, 1), cB + hstep + kstep, voffB);
        PG8_WAIT_V(6); PG8_BAR;
    } else {
        PG8_STAGE(PG8_SB(0, 0), cB, voffB); PG8_STAGE(PG8_SA(0, 0), cA, voffA); PG8_STAGE(PG8_SB(0, 1), cB + hstep, voffB); PG8_STAGE(PG8_SA(0, 1), cA + hstep, voffA);
        if (wr == 1) PG8_BAR;
        PG8_WAIT_V(4); PG8_BAR;
        PG8_STAGE(PG8_SB(1, 0), cB + kstep, voffB); PG8_STAGE(PG8_SA(1, 0), cA + kstep, voffA); PG8_STAGE(PG8_SB(1, 1), cB + hstep + kstep, voffB);
        PG8_WAIT_V(6); PG8_BAR;
    }
    for (;;) {
        const bool has_next = S.next(ui + 1, nxt);
        const char* nA = has_next ? (const char*)g.A + (size_t)nxt.pm * tstep : cA; const char* nB = has_next ? (const char*)g.Bt + (size_t)nxt.pn * tstep : cB;
        for (int t = 0; t < nt; t += 2) {
            const bool last = (t == nt - 2);
            const char* a1 = cA + (size_t)(t + 1) * kstep;
            const char* a2 = last ? nA : cA + (size_t)(t + 2) * kstep; const char* b2 = last ? nB : cB + (size_t)(t + 2) * kstep;
            const char* a3 = a2 + kstep; const char* b3 = b2 + kstep;
            if (last && has_next) S.a_ready(nxt);
            if constexpr (SP2) {
            PG8_LDB(B0, 0, 0); PG8_LDB(B1, 0, 1); PG8_SCHED; PG8_LDA(At, 0, 0); PG8_STAGE(PG8_SA(1, 1), a1 + hstep, voffA);
            PG8_WAIT_V(8); PG8_WAIT_L(0); PG8_BAR; PG8_MMA(0, 0, At, B0); PG8_MMA(0, 1, At, B1); PG8_BAR; PG8_SCHED;
            PG8_LDA(At, 0, 1); PG8_STAGE(PG8_SB(0, 0), b2, voffB); PG8_STAGE(PG8_SB(0, 1), b2 + hstep, voffB); PG8_STAGE(PG8_SA(0, 0), a2, voffA);
            PG8_WAIT_V(8); PG8_WAIT_L(0); PG8_BAR; PG8_MMA(1, 0, At, B0); PG8_MMA(1, 1, At, B1); PG8_BAR; PG8_SCHED;
            PG8_LDB(B0, 1, 0); PG8_LDB(B1, 1, 1); PG8_SCHED; PG8_LDA(At, 1, 0); PG8_STAGE(PG8_SA(0, 1), a2 + hstep, voffA);
            PG8_WAIT_V(8); PG8_WAIT_L(0); PG8_BAR; PG8_MMA(0, 0, At, B0); PG8_MMA(0, 1, At, B1); PG8_BAR; PG8_SCHED;
            PG8_LDA(At, 1, 1); PG8_STAGE(PG8_SB(1, 0), b3, voffB); PG8_STAGE(PG8_SB(1, 1), b3 + hstep, voffB); PG8_STAGE(PG8_SA(1, 0), a3, voffA);
            PG8_WAIT_V(8); PG8_WAIT_L(0); PG8_BAR; PG8_MMA(1, 0, At, B0); PG8_MMA(1, 1, At, B1); PG8_BAR; PG8_SCHED;
            } else {
            PG8_LDB(B0, 0, 0); PG8_SCHED; PG8_LDA(At, 0, 0); PG8_STAGE(PG8_SA(1, 1), a1 + hstep, voffA);
            PG8_WAIT_L(8); PG8_BAR; PG8_WAIT_L(0); PG8_MMA(0, 0, At, B0); PG8_BAR; PG8_SCHED;
            PG8_LDB(B1, 0, 1); PG8_STAGE(PG8_SB(0, 0), b2, voffB);
            PG8_BAR; PG8_WAIT_L(0); PG8_MMA(0, 1, At, B1); PG8_BAR;
            PG8_LDA(At, 0, 1); PG8_STAGE(PG8_SA(0, 0), a2, voffA);
            PG8_BAR; PG8_WAIT_L(0); PG8_MMA(1, 0, At, B0); PG8_BAR; PG8_SCHED;
            PG8_STAGE(PG8_SB(0, 1), b2 + hstep, voffB);
            PG8_WAIT_V(6); PG8_BAR; PG8_MMA(1, 1, At, B1); PG8_BAR;
            PG8_LDB(B0, 1, 0); PG8_SCHED; PG8_LDA(At, 1, 0); PG8_STAGE(PG8_SA(0, 1), a2 + hstep, voffA);
            PG8_WAIT_L(8); PG8_BAR; PG8_WAIT_L(0); PG8_MMA(0, 0, At, B0); PG8_BAR; PG8_SCHED;
            PG8_LDB(B1, 1, 1); PG8_STAGE(PG8_SB(1, 0), b3, voffB);
            PG8_BAR; PG8_WAIT_L(0); PG8_MMA(0, 1, At, B1); PG8_BAR;
            PG8_LDA(At, 1, 1); PG8_STAGE(PG8_SA(1, 0), a3, voffA);
            PG8_BAR; PG8_WAIT_L(0); PG8_MMA(1, 0, At, B0); PG8_BAR; PG8_SCHED;
            PG8_STAGE(PG8_SB(1, 1), b3 + hstep, voffB);
            PG8_WAIT_V(6); PG8_BAR; PG8_MMA(1, 1, At, B1); PG8_BAR;
            }
        }
        if constexpr (ALIGN_EPI) { if (wr == 0) PG8_BAR; }
        if constexpr (!Epi::AFTER_DRAIN) { E(acc, cur, wr, wc, fr, fq); S.done(cur); }
        if (!has_next) break;
#pragma unroll
        for (int a = 0; a < 2; ++a)
#pragma unroll
            for (int b = 0; b < 2; ++b)
#pragma unroll
                for (int m = 0; m < 4; ++m)
#pragma unroll
                    for (int n = 0; n < 2; ++n) acc[a][b][m][n] = (f32x4){0.f, 0.f, 0.f, 0.f};
        cur = nxt; cA = nA; cB = nB; ++ui;
        if constexpr (ALIGN_EPI) { if (wr == 1) PG8_BAR; }
    }
    PG8_WAIT_V(0);
    if constexpr (!ALIGN_EPI) { if (wr == 0) PG8_BAR; }
    PG8_BAR;
    if constexpr (Epi::AFTER_DRAIN) { E.fused(acc, cur, wr, wc, fr, fq, lds, wid, lane); S.done(cur); }
#undef PG8_SA
#undef PG8_SB
#undef PG8_STAGE
#undef PG8_LDA
#undef PG8_LDB
#undef PG8_MMA
#undef PG8_WAIT_V
#undef PG8_WAIT_L
#undef PG8_BAR
#undef PG8_SCHED
}
}
namespace att {
typedef unsigned short bf16_t;
using bf16x8 = __attribute__((ext_vector_type(8))) short;
using s16x4 = __attribute__((ext_vector_type(4))) short;
using f32x16 = __attribute__((ext_vector_type(16))) float;
using f32x4 = __attribute__((ext_vector_type(4))) float;
using u32x4 = __attribute__((ext_vector_type(4))) unsigned;
typedef short v4i16_t __attribute__((ext_vector_type(4)));
typedef __attribute__((address_space(3))) const char* lds_cptr;
typedef __attribute__((address_space(3))) char* lds_ptr;
typedef __attribute__((address_space(3))) float* lds_fptr;
constexpr int SEQ = 4096, DM = 1024, KVBLK = 64, NT = SEQ / KVBLK;
constexpr float L2E = 1.4426950408889634f, EPS = 1e-6f;
#define SBAR() __builtin_amdgcn_sched_barrier(0)
__device__ __forceinline__ int crow(int r, int hi) { return (r & 3) + 8 * (r >> 2) + 4 * hi; }
__device__ __forceinline__ void glds16(const void* gsrc, unsigned lds_dst) { unsigned keep;
    asm volatile("s_mov_b32 %0, m0\n\ts_mov_b32 m0, %2\n\ts_nop 0\n\tglobal_load_lds_dwordx4 %1, off\n\ts_mov_b32 m0, %0" : "=&s"(keep) : "v"(gsrc), "s"(lds_dst) : "memory"); }
typedef float f32x2_t __attribute__((ext_vector_type(2))); typedef __bf16 bf16x2_t __attribute__((ext_vector_type(2)));
__device__ __forceinline__ unsigned cvtpk(float lo, float hi) { f32x2_t v = {lo, hi}; bf16x2_t b = __builtin_convertvector(v, bf16x2_t); return __builtin_bit_cast(unsigned, b); }
__device__ __forceinline__ s16x4 vtr(lds_cptr p) { return __builtin_bit_cast(s16x4, __builtin_amdgcn_ds_read_tr16_b64_v4i16((__attribute__((address_space(3))) v4i16_t*)p)); }
#define WAIT_BAR(N) asm volatile("s_waitcnt vmcnt(" #N ") lgkmcnt(0)\n\ts_barrier" ::: "memory")
__device__ __forceinline__ float wave_max(float v) { return wmax64(v); }
__device__ __forceinline__ float wave_sum(float v) { return wsum64(v); }
__device__ __forceinline__ int t5_bucket(int rel) {
    const int n = rel < 0 ? -rel : rel; int b;
    if (n < 8) b = n; else { const int l = 2 + (31 - __clz(n * n)); b = l < 15 ? l : 15; }
    return b + (rel > 0 ? 16 : 0);
}

constexpr int D_SLOT = 32768, D_NSLOT = 3, D_STG = 17408;
#ifndef MK_ATT_DP
#define MK_ATT_DP 1
#endif
#ifndef MK_ATT_F32SUM
#define MK_ATT_F32SUM 1
#endif
template <int PROBE = 0  >
__device__ __forceinline__ void d_unit(int b, int h, int qb, const bf16_t* Q, const bf16_t* K, const bf16_t* V, bf16_t* O, const float* t5, const float* qg, const float* kg,
                                       const float* lamp, char* shm, char* aux, const int wave_in, const int tmask = -1  ) {
    const int lane_ = lane_id_v();
    const int lane = lane_, tid = wave_in * 64 + lane, r32 = lane & 31, hi = lane >> 5;
    const int wid = wave_in, qi = wid & 3, c = wid >> 2;
    const long rowbase = (long)b * SEQ; const int q0 = qb * 128 + qi * 32;
    const lds_fptr tbl = (lds_fptr)aux; const lds_fptr wsf = (lds_fptr)(aux + 1024) + wid * 64;
    const float c_lo = t5[15 * 8 + h] * L2E, c_hi = t5[31 * 8 + h] * L2E;
    if (tid < 256) tbl[tid] = t5[t5_bucket(tid - 128) * 8 + h] * L2E - c_hi;
    const float fscale = __builtin_amdgcn_exp2f(c_lo - c_hi);
    const float lam = expf(wave_sum(lamp[lane] * lamp[64 + lane])) - expf(wave_sum(lamp[128 + lane] * lamp[192 + lane])) + 0.2f;
    const unsigned lds0 = (unsigned)(uintptr_t)shm;
    const bf16_t* ksrc = (PROBE & 64) ? K + rowbase * DM + h * 128 + wid * 512 + lane * 8 : K + (rowbase + lane) * DM + h * 128 + wid * 8;
    const bf16_t* vsrc = (PROBE & 64) ? V + rowbase * DM + h * 128 + wid * 512 + lane * 8 : V + (rowbase + 16 * (wid & 3) + (lane >> 2)) * DM + h * 128 + (wid >> 2) * 32 + (lane & 3) * 8;
    const unsigned dst0 = lds0 + wid * 1024;
#define DMA_K(t, slot) do { const bf16_t* ks_ = ksrc + (long)((t) & tmask) * KVBLK * DM; const unsigned d_ = (unsigned)__builtin_amdgcn_readfirstlane(dst0 + (slot)); glds16(ks_, d_); glds16(ks_ + 64, d_ + 8192); } while (0)
#define DMA_V(t, slot) do { const bf16_t* vs_ = vsrc + (long)((t) & tmask) * KVBLK * DM; const unsigned d_ = (unsigned)__builtin_amdgcn_readfirstlane(dst0 + (slot)); glds16(vs_, d_ + 16384); glds16(vs_ + 64, d_ + 24576); } while (0)
#define DMA1(t, slot, which) do { const unsigned d_ = (unsigned)__builtin_amdgcn_readfirstlane(dst0 + (slot)); \
        if ((which) == 0) glds16(ksrc + (long)((t) & tmask) * KVBLK * DM, d_); else if ((which) == 1) glds16(ksrc + (long)((t) & tmask) * KVBLK * DM + 64, d_ + 8192); \
        else if ((which) == 2) glds16(vsrc + (long)((t) & tmask) * KVBLK * DM, d_ + 16384); else glds16(vsrc + (long)((t) & tmask) * KVBLK * DM + 64, d_ + 24576); } while (0)
    const bf16_t* Qw = Q + (rowbase + q0 + r32) * DM + h * 128 + c * 64 + hi * 8;
    bf16x8 qr[4];
#pragma unroll
    for (int d0 = 0; d0 < 4; ++d0) qr[d0] = *(const bf16x8*)(Qw + d0 * 16);
    DMA_K(0, 0); DMA_V(0, 0); DMA_K(1, D_SLOT); DMA_K(2, 2 * D_SLOT);
    const lds_cptr shm3 = (lds_cptr)shm;
    const lds_cptr kp0 = shm3 + c * 8192 + hi * 1024 + r32 * 16;
    const lds_cptr vp0 = shm3 + 16384 + ((lane >> 4) & 1) * 32 + (lane & 3) * 8 + (4 * hi + ((lane & 15) >> 2)) * 64;
    f32x16 o[4]; o[0] = f32x16{}; o[1] = f32x16{}; o[2] = f32x16{}; o[3] = f32x16{};
    float l_reg = 0.f;
    const int tb0 = q0 >= 154 ? ((q0 - 154) >> 6) + 1 : 0; int tb1 = (q0 + 122 + 63) >> 6; tb1 = tb1 > NT ? NT : tb1;
    const int relq = 128 - (q0 + r32);
    bf16x8 kf[8]; f32x16 C0, C1; const f32x16 zero16 = f32x16{};
    s16x4 vlo[8], vhi[8]; u32x4 pa0, pa1, pa2, pa3, pb0, pb1, pb2, pb3;
#define KLD(j, kp) do { kf[2 * (j)] = *(const __attribute__((address_space(3))) bf16x8*)((kp) + (j) * 2048); kf[2 * (j) + 1] = *(const __attribute__((address_space(3))) bf16x8*)((kp) + (j) * 2048 + 512); } while (0)
#define BAND_ADD(t) do { const int rb_ = 64 * (t) + relq; \
        _Pragma("unroll") for (int r = 0; r < 16; ++r) { int i0 = rb_ + crow(r, hi); int i1 = i0 + 32; \
            i0 = i0 < 0 ? 0 : (i0 > 255 ? 255 : i0); i1 = i1 < 0 ? 0 : (i1 > 255 ? 255 : i1); C0[r] += tbl[i0]; C1[r] += tbl[i1]; } } while (0)
#define EX(v) ((PROBE & 1) ? (v) * 0.001f : __builtin_amdgcn_exp2f(v))
#define PIN(x) asm volatile("" : "+v"(x))
    WAIT_BAR(6);
    KLD(0, kp0); KLD(1, kp0); KLD(2, kp0); KLD(3, kp0);
#pragma unroll
    for (int d0 = 0; d0 < 4; ++d0) {
        if (d0 == 0) { C0 = __builtin_amdgcn_mfma_f32_32x32x16_bf16(kf[0], qr[0], zero16, 0, 0, 0); C1 = __builtin_amdgcn_mfma_f32_32x32x16_bf16(kf[1], qr[0], zero16, 0, 0, 0); }
        else { C0 = __builtin_amdgcn_mfma_f32_32x32x16_bf16(kf[2 * d0], qr[d0], C0, 0, 0, 0); C1 = __builtin_amdgcn_mfma_f32_32x32x16_bf16(kf[2 * d0 + 1], qr[d0], C1, 0, 0, 0); } }
    if (0 >= tb0 && 0 < tb1) BAND_ADD(0);
    {
#pragma unroll
      for (int r = 0; r < 16; ++r) { C0[r] = EX(C0[r]); C1[r] = EX(C1[r]); }
      if (MK_ATT_F32SUM) { float s_ = 0.f;
#pragma unroll
        for (int r = 0; r < 16; ++r) s_ += C0[r] + C1[r];
        l_reg += s_; }
      pa0 = (u32x4){cvtpk(C0[0], C0[1]), cvtpk(C0[2], C0[3]), cvtpk(C0[4], C0[5]), cvtpk(C0[6], C0[7])}; pa1 = (u32x4){cvtpk(C0[8], C0[9]), cvtpk(C0[10], C0[11]), cvtpk(C0[12], C0[13]), cvtpk(C0[14], C0[15])};
      pa2 = (u32x4){cvtpk(C1[0], C1[1]), cvtpk(C1[2], C1[3]), cvtpk(C1[4], C1[5]), cvtpk(C1[6], C1[7])}; pa3 = (u32x4){cvtpk(C1[8], C1[9]), cvtpk(C1[10], C1[11]), cvtpk(C1[12], C1[13]), cvtpk(C1[14], C1[15])}; }
    WAIT_BAR(0);
    DMA_K(3, 0); DMA_V(1, D_SLOT);
    KLD(0, kp0 + D_SLOT); KLD(1, kp0 + D_SLOT); KLD(2, kp0 + D_SLOT); KLD(3, kp0 + D_SLOT);
    WAIT_BAR(4);
    int sl_prev = 0, sl_cur = D_SLOT, sl_next = 2 * D_SLOT;
#define VFR(i) (bf16x8){vlo[i][0], vlo[i][1], vlo[i][2], vlo[i][3], vhi[i][0], vhi[i][1], vhi[i][2], vhi[i][3]}
#define VRD(j) do { if ((PROBE & 2) && (j) > 7) break; vlo[(j) & 7] = vtr(vp_ + ((((j) & 3) * 4 + ((j) >> 2)) * 1024)); vhi[(j) & 7] = vtr(vp_ + ((((j) & 3) * 4 + ((j) >> 2)) * 1024 + 512)); } while (0)
#define DOT2(W) asm volatile("v_dot2c_f32_bf16 %0, %1, %2" : "+v"(sacc) : "v"(W), "v"(0x3f803f80u))
#define GAPA(MF, J, W0, W1) do { MF; VRD(J); if (!MK_ATT_F32SUM) { DOT2(W0); DOT2(W1); } SBAR(); } while (0)
#define GAPB(J, PCK, PNK, CS, B) do { if (!(PROBE & 8)) o[(J) & 3] = __builtin_amdgcn_mfma_f32_32x32x16_bf16(__builtin_bit_cast(bf16x8, PCK), VFR((J) & 7), o[(J) & 3], 0, 0, 0); \
        { const float e0_ = EX(CS[B]), e1_ = EX(CS[(B) + 1]); if (MK_ATT_F32SUM) { asm volatile("v_add_f32 %0, %0, %1" : "+v"(sum0_) : "v"(e0_)); asm volatile("v_add_f32 %0, %0, %1" : "+v"(sum1_) : "v"(e1_)); } PNK[(J) & 3] = cvtpk(e0_, e1_); PIN(PNK); } } while (0)
#define STEP(t, PC0, PC1, PC2, PC3, PN0, PN1, PN2, PN3) do { SBAR(); \
        const lds_cptr vp_ = vp0 + sl_prev; float sacc = 0.f, sum0_ = 0.f, sum1_ = 0.f; \
          \
        GAPA(C0 = __builtin_amdgcn_mfma_f32_32x32x16_bf16(kf[0], qr[0], zero16, 0, 0, 0), 0, PC0[0], PC0[1]); \
        GAPA(C1 = __builtin_amdgcn_mfma_f32_32x32x16_bf16(kf[1], qr[0], zero16, 0, 0, 0), 1, PC0[2], PC0[3]); \
        GAPA(C0 = __builtin_amdgcn_mfma_f32_32x32x16_bf16(kf[2], qr[1], C0, 0, 0, 0),     2, PC1[0], PC1[1]); \
        GAPA(C1 = __builtin_amdgcn_mfma_f32_32x32x16_bf16(kf[3], qr[1], C1, 0, 0, 0),     3, PC1[2], PC1[3]); \
        GAPA(C0 = __builtin_amdgcn_mfma_f32_32x32x16_bf16(kf[4], qr[2], C0, 0, 0, 0),     4, PC2[0], PC2[1]); \
        GAPA(C1 = __builtin_amdgcn_mfma_f32_32x32x16_bf16(kf[5], qr[2], C1, 0, 0, 0),     5, PC2[2], PC2[3]); \
        GAPA(C0 = __builtin_amdgcn_mfma_f32_32x32x16_bf16(kf[6], qr[3], C0, 0, 0, 0),     6, PC3[0], PC3[1]); \
        GAPA(C1 = __builtin_amdgcn_mfma_f32_32x32x16_bf16(kf[7], qr[3], C1, 0, 0, 0),     7, PC3[2], PC3[3]); \
        l_reg += sacc; \
        if (!(PROBE & 16)) { if (MK_ATT_DP != 1 && (t) + 3 < NT) DMA_K((t) + 3, sl_cur);               \
        if (MK_ATT_DP == 0 && (t) + 1 < NT) DMA_V((t) + 1, sl_next); }            \
        if (!(PROBE & 32) && (t) >= tb0 && (t) < tb1) BAND_ADD(t); \
        SBAR(); \
          \
        const lds_cptr kn_ = kp0 + sl_next; const bool gl_ = (t) + 1 < NT; \
        GAPB(0, PC0, PN0, C0, 0);   VRD(8);  \
        GAPB(1, PC0, PN0, C0, 2);   VRD(9);  \
        GAPB(2, PC0, PN0, C0, 4);   VRD(10); \
        GAPB(3, PC0, PN0, C0, 6);   VRD(11); SBAR(); \
        GAPB(4, PC1, PN1, C0, 8);   VRD(12); \
        GAPB(5, PC1, PN1, C0, 10);  VRD(13); \
        GAPB(6, PC1, PN1, C0, 12);  VRD(14); \
        GAPB(7, PC1, PN1, C0, 14);  VRD(15); SBAR(); \
        if (MK_ATT_DP != 0 && !(PROBE & 16)) { if (MK_ATT_DP == 1 && (t) + 3 < NT) DMA_K((t) + 3, sl_cur); if ((t) + 1 < NT) DMA_V((t) + 1, sl_next); SBAR(); } \
        GAPB(8, PC2, PN2, C1, 0);   if (gl_ && !(PROBE & 4)) KLD(0, kn_); \
        GAPB(9, PC2, PN2, C1, 2);   if (gl_ && !(PROBE & 4)) KLD(1, kn_); \
        GAPB(10, PC2, PN2, C1, 4);  if (gl_ && !(PROBE & 4)) KLD(2, kn_); \
        GAPB(11, PC2, PN2, C1, 6);  if (gl_ && !(PROBE & 4)) KLD(3, kn_); SBAR(); \
        GAPB(12, PC3, PN3, C1, 8);  \
        GAPB(13, PC3, PN3, C1, 10); \
        GAPB(14, PC3, PN3, C1, 12); \
        GAPB(15, PC3, PN3, C1, 14); SBAR(); \
        if ((t) == tb0 && tb0 > 0) {                            \
            l_reg *= fscale; \
            _Pragma("unroll") for (int d_ = 0; d_ < 4; ++d_) _Pragma("unroll") for (int r = 0; r < 16; ++r) o[d_][r] *= fscale; } \
        if (MK_ATT_F32SUM) l_reg += sum0_ + sum1_;              \
          \
        if ((t) + 3 < NT) { WAIT_BAR(4); } else if ((t) + 1 < NT) { WAIT_BAR(2); } else { WAIT_BAR(0); } \
        sl_prev = sl_cur; sl_cur = sl_next; sl_next = (sl_next == (D_NSLOT - 1) * D_SLOT) ? 0 : sl_next + D_SLOT; } while (0)
    int t = 1;
#pragma unroll 1
    for (; t + 1 < NT; t += 2) {
        STEP(t, pa0, pa1, pa2, pa3, pb0, pb1, pb2, pb3);
        STEP(t + 1, pb0, pb1, pb2, pb3, pa0, pa1, pa2, pa3);
    }
    STEP(t, pa0, pa1, pa2, pa3, pb0, pb1, pb2, pb3);
    { const lds_cptr vp_ = vp0 + sl_prev; float sacc = 0.f;
      if (!MK_ATT_F32SUM) {
#pragma unroll
        for (int i_ = 0; i_ < 4; ++i_) { DOT2(pb0[i_]); DOT2(pb1[i_]); DOT2(pb2[i_]); DOT2(pb3[i_]); } }
      l_reg += sacc;
#pragma unroll
      for (int d0 = 0; d0 < 4; ++d0) {
#define PV1(KS, PW) do { const s16x4 lo_ = vtr(vp_ + (d0 * 4 + (KS)) * 1024), hh_ = vtr(vp_ + (d0 * 4 + (KS)) * 1024 + 512); \
          o[d0] = __builtin_amdgcn_mfma_f32_32x32x16_bf16(__builtin_bit_cast(bf16x8, PW), (bf16x8){lo_[0], lo_[1], lo_[2], lo_[3], hh_[0], hh_[1], hh_[2], hh_[3]}, o[d0], 0, 0, 0); } while (0)
          PV1(0, pb0); PV1(1, pb1); PV1(2, pb2); PV1(3, pb3);
#undef PV1
      } }
#undef STEP
#undef GAPA
#undef DOT2
#undef GAPB
#undef VFR
#undef VRD
#undef PIN
#undef EX
#undef KLD
#undef BAND_ADD
#undef DMA_K
#undef DMA1
#undef DMA_V
    { auto rr = __builtin_amdgcn_permlane32_swap(__float_as_uint(l_reg), __float_as_uint(l_reg), false, false); l_reg = __uint_as_float(rr[0]) + __uint_as_float(rr[1]); }
    if (hi == 0) wsf[r32] = l_reg;
    asm volatile("s_waitcnt lgkmcnt(0)" ::: "memory");
    float rli[16];
#pragma unroll
    for (int r = 0; r < 16; ++r) rli[r] = (c == 0 ? 1.0f : lam) / wsf[crow(r, hi)];
    asm volatile("s_waitcnt lgkmcnt(0)\n\ts_barrier" ::: "memory");
    const lds_fptr stg = (lds_fptr)(shm + qi * D_STG);
    if (c == 1) {
#pragma unroll
        for (int d0 = 0; d0 < 4; ++d0)
#pragma unroll
            for (int r = 0; r < 16; ++r) stg[(d0 * 16 + r) * 64 + lane] = o[d0][r] * rli[r];
    }
    asm volatile("s_waitcnt lgkmcnt(0)\n\ts_barrier" ::: "memory");
    if (c == 0) {
#pragma unroll
        for (int d0 = 0; d0 < 4; ++d0)
#pragma unroll
            for (int r = 0; r < 16; ++r) o[d0][r] = o[d0][r] * rli[r] - stg[(d0 * 16 + r) * 64 + lane];
        asm volatile("s_waitcnt lgkmcnt(0)" ::: "memory");
#pragma unroll
        for (int d0 = 0; d0 < 4; ++d0)
#pragma unroll
            for (int r = 0; r < 16; ++r) stg[crow(r, hi) * 132 + d0 * 32 + r32] = o[d0][r];
        asm volatile("s_waitcnt lgkmcnt(0)" ::: "memory");
        const int row = lane >> 1, half = lane & 1;
        f32x4 v[16]; float ss = 0.f;
#pragma unroll
        for (int i = 0; i < 16; ++i) { v[i] = *(const __attribute__((address_space(3))) f32x4*)(stg + row * 132 + half * 64 + 4 * i); ss += (v[i][0] * v[i][0] + v[i][1] * v[i][1]) + (v[i][2] * v[i][2] + v[i][3] * v[i][3]); }
        ss = xadd<1>(ss);
        const float rn = 1.0f / sqrtf(ss * (1.0f / 128.0f) + EPS);
        bf16_t* Ow = O + (rowbase + q0 + row) * DM + h * 128 + half * 64;
#pragma unroll
        for (int i = 0; i < 8; ++i) { const f32x4 a = v[2 * i] * rn, bq = v[2 * i + 1] * rn;
            u32x4 w = {cvtpk(a[0], a[1]), cvtpk(a[2], a[3]), cvtpk(bq[0], bq[1]), cvtpk(bq[2], bq[3])};
            *(u32x4*)(Ow + 8 * i) = w; }
    }
    asm volatile("s_waitcnt lgkmcnt(0)\n\ts_barrier" ::: "memory");
}

constexpr int S_KSLOT = 16384, S_NK = 3, S_VBASE = 49152, S_VSLOT = 16384, S_NV = 4;
template <int PROBE = 0>
__device__ __forceinline__ void d_unit_s(int b, int h, int qb, const bf16_t* Q, const bf16_t* K, const bf16_t* V, bf16_t* O, const float* t5, const float* qg, const float* kg,
                                         const float* lamp, char* shm, char* aux, const int wave_in) {
    const int lane_ = lane_id_v();
    const int lane = lane_, tid = wave_in * 64 + lane, r32 = lane & 31, hi = lane >> 5;
    const int wid = wave_in, qi = wid & 3, c = wid >> 2;
    const long rowbase = (long)b * SEQ; const int q0 = qb * 128 + qi * 32;
    const lds_fptr tbl = (lds_fptr)aux; const lds_fptr wsf = (lds_fptr)(aux + 1024) + wid * 64;
    const float c_lo = t5[15 * 8 + h] * L2E, c_hi = t5[31 * 8 + h] * L2E;
    if (tid < 256) tbl[tid] = t5[t5_bucket(tid - 128) * 8 + h] * L2E - c_hi;
    const float fscale = __builtin_amdgcn_exp2f(c_lo - c_hi);
    const unsigned lds0 = (unsigned)(uintptr_t)shm;
    const bf16_t* ksrc = K + (rowbase + lane) * DM + h * 128 + wid * 8;
    const bf16_t* vsrc = V + (rowbase + 16 * (wid & 3) + (lane >> 2)) * DM + h * 128 + (wid >> 2) * 32 + (lane & 3) * 8;
    const unsigned dst0 = lds0 + wid * 1024;
#define SDMA_K(t, ks) do { const bf16_t* s_ = ksrc + (long)(t) * KVBLK * DM; const unsigned d_ = (dst0 + (ks) * S_KSLOT); glds16(s_, d_); glds16(s_ + 64, d_ + 8192); } while (0)
#define SDMA_V(t, vs) do { const bf16_t* s_ = vsrc + (long)(t) * KVBLK * DM; const unsigned d_ = (dst0 + S_VBASE + (vs) * S_VSLOT); glds16(s_, d_); glds16(s_ + 64, d_ + 8192); } while (0)
    const bf16_t* Qw = Q + (rowbase + q0 + r32) * DM + h * 128 + c * 64 + hi * 8;
    bf16x8 qr[4];
#pragma unroll
    for (int d0 = 0; d0 < 4; ++d0) qr[d0] = *(const bf16x8*)(Qw + d0 * 16);
    const bf16_t* kq = ksrc; const bf16_t* vq = vsrc;
#define SDMA_KQ(ks) do { const unsigned d_ = (dst0 + (ks) * S_KSLOT); glds16(kq, d_); glds16(kq + 64, d_ + 8192); kq += KVBLK * DM; } while (0)
#define SDMA_VQ(vs) do { const unsigned d_ = (dst0 + S_VBASE + (vs) * S_VSLOT); glds16(vq, d_); glds16(vq + 64, d_ + 8192); vq += KVBLK * DM; } while (0)
    SDMA_KQ(0); SDMA_KQ(1); SDMA_VQ(0); SDMA_KQ(2); SDMA_VQ(1);
    const lds_cptr shm3 = (lds_cptr)shm;
    const lds_cptr kp0 = shm3 + c * 8192 + hi * 1024 + r32 * 16;
    const lds_cptr vp0 = shm3 + S_VBASE + ((lane >> 4) & 1) * 32 + (lane & 3) * 8 + (4 * hi + ((lane & 15) >> 2)) * 64;
    f32x16 o[4]; o[0] = f32x16{}; o[1] = f32x16{}; o[2] = f32x16{}; o[3] = f32x16{};
    float l_reg = 0.f;
    const int tb0 = q0 >= 154 ? ((q0 - 154) >> 6) + 1 : 0; int tb1 = (q0 + 122 + 63) >> 6; tb1 = tb1 > NT ? NT : tb1;
    const int relq = 128 - (q0 + r32);
    bf16x8 F[8]; f32x16 C0, C1; const f32x16 zero16 = f32x16{};
    u32x4 pa0, pa1, pa2, pa3, pb0, pb1, pb2, pb3;
#define EX(v) __builtin_amdgcn_exp2f(v)
#define PIN(x) asm volatile("" : "+v"(x))
#define DOT2(W) asm volatile("v_dot2c_f32_bf16 %0, %1, %2" : "+v"(sacc) : "v"(W), "v"(0x3f803f80u))
#define BAND_ADD(t) do { const int rb_ = 64 * (t) + relq; \
        _Pragma("unroll") for (int r = 0; r < 16; ++r) { int i0 = rb_ + crow(r, hi); int i1 = i0 + 32; \
            i0 = i0 < 0 ? 0 : (i0 > 255 ? 255 : i0); i1 = i1 < 0 ? 0 : (i1 > 255 ? 255 : i1); C0[r] += tbl[i0]; C1[r] += tbl[i1]; } } while (0)
#define S_LK(t) do { const lds_cptr kp_ = kp0 + ((t) % S_NK) * S_KSLOT; _Pragma("unroll") for (int j = 0; j < 4; ++j) { \
        F[2 * j] = *(const __attribute__((address_space(3))) bf16x8*)(kp_ + j * 2048); F[2 * j + 1] = *(const __attribute__((address_space(3))) bf16x8*)(kp_ + j * 2048 + 512); } } while (0)
#define S_LV(tv, DB0) do { const lds_cptr vp_ = vp0 + ((tv) % S_NV) * S_VSLOT; _Pragma("unroll") for (int j = 0; j < 8; ++j) { \
        const s16x4 lo_ = vtr(vp_ + (((DB0) + (j & 1)) * 4 + (j >> 1)) * 1024), hh_ = vtr(vp_ + (((DB0) + (j & 1)) * 4 + (j >> 1)) * 1024 + 512); \
        F[j] = (bf16x8){lo_[0], lo_[1], lo_[2], lo_[3], hh_[0], hh_[1], hh_[2], hh_[3]}; } } while (0)
#define S_QK(PC0, PC1, PC2, PC3) do { float sacc = 0.f; SBAR(); \
        C0 = __builtin_amdgcn_mfma_f32_32x32x16_bf16(F[0], qr[0], zero16, 0, 0, 0); DOT2(PC0[0]); DOT2(PC0[1]); SBAR(); \
        C1 = __builtin_amdgcn_mfma_f32_32x32x16_bf16(F[1], qr[0], zero16, 0, 0, 0); DOT2(PC0[2]); DOT2(PC0[3]); SBAR(); \
        C0 = __builtin_amdgcn_mfma_f32_32x32x16_bf16(F[2], qr[1], C0, 0, 0, 0);     DOT2(PC1[0]); DOT2(PC1[1]); SBAR(); \
        C1 = __builtin_amdgcn_mfma_f32_32x32x16_bf16(F[3], qr[1], C1, 0, 0, 0);     DOT2(PC1[2]); DOT2(PC1[3]); SBAR(); \
        C0 = __builtin_amdgcn_mfma_f32_32x32x16_bf16(F[4], qr[2], C0, 0, 0, 0);     DOT2(PC2[0]); DOT2(PC2[1]); SBAR(); \
        C1 = __builtin_amdgcn_mfma_f32_32x32x16_bf16(F[5], qr[2], C1, 0, 0, 0);     DOT2(PC2[2]); DOT2(PC2[3]); SBAR(); \
        C0 = __builtin_amdgcn_mfma_f32_32x32x16_bf16(F[6], qr[3], C0, 0, 0, 0);     DOT2(PC3[0]); DOT2(PC3[1]); SBAR(); \
        C1 = __builtin_amdgcn_mfma_f32_32x32x16_bf16(F[7], qr[3], C1, 0, 0, 0);     DOT2(PC3[2]); DOT2(PC3[3]); SBAR(); \
        l_reg += sacc; } while (0)
#define S_PVG(J, OB, PCK, PNK, CS) do { o[(OB) + ((J) & 1)] = __builtin_amdgcn_mfma_f32_32x32x16_bf16(__builtin_bit_cast(bf16x8, PCK), F[J], o[(OB) + ((J) & 1)], 0, 0, 0); \
        { const float e0_ = EX(CS[2 * (J)]), e1_ = EX(CS[2 * (J) + 1]); PNK[(J) & 3] = cvtpk(e0_, e1_); PIN(PNK); } } while (0)
#define S_PV(OB, PC0, PC1, PC2, PC3, PNA, PNB, CS) do { SBAR(); \
        S_PVG(0, OB, PC0, PNA, CS); S_PVG(1, OB, PC0, PNA, CS); SBAR(); S_PVG(2, OB, PC1, PNA, CS); S_PVG(3, OB, PC1, PNA, CS); SBAR(); \
        S_PVG(4, OB, PC2, PNB, CS); S_PVG(5, OB, PC2, PNB, CS); SBAR(); S_PVG(6, OB, PC3, PNB, CS); S_PVG(7, OB, PC3, PNB, CS); SBAR(); \
        } while (0)
#define S_H1(t, PC0, PC1, PC2, PC3) do { S_LK(t); S_QK(PC0, PC1, PC2, PC3); S_LV((t) - 1, 0); if ((t) >= tb0 && (t) < tb1) BAND_ADD(t); SBAR(); } while (0)
#define S_H2(t, PC0, PC1, PC2, PC3, PN0, PN1, PN2, PN3) do { S_PV(0, PC0, PC1, PC2, PC3, PN0, PN1, C0); S_LV((t) - 1, 2); S_PV(2, PC0, PC1, PC2, PC3, PN2, PN3, C1); \
        if ((t) == tb0 && tb0 > 0) { l_reg *= fscale; _Pragma("unroll") for (int d_ = 0; d_ < 4; ++d_) _Pragma("unroll") for (int r = 0; r < 16; ++r) o[d_][r] *= fscale; } SBAR(); } while (0)
#define S_END(tau) do { const bool gk_ = (tau) + 2 < NT, gv_ = (tau) + 1 < NT; \
        if (gk_) SDMA_KQ(((tau) + 2) % S_NK); if (gv_) SDMA_VQ(((tau) + 1) % S_NV); \
        if (gk_) { WAIT_BAR(4); } else if (gv_) { WAIT_BAR(2); } else { WAIT_BAR(0); } } while (0)
    WAIT_BAR(8);
    S_LK(0);
#pragma unroll
    for (int d0 = 0; d0 < 4; ++d0) {
        if (d0 == 0) { C0 = __builtin_amdgcn_mfma_f32_32x32x16_bf16(F[0], qr[0], zero16, 0, 0, 0); C1 = __builtin_amdgcn_mfma_f32_32x32x16_bf16(F[1], qr[0], zero16, 0, 0, 0); }
        else { C0 = __builtin_amdgcn_mfma_f32_32x32x16_bf16(F[2 * d0], qr[d0], C0, 0, 0, 0); C1 = __builtin_amdgcn_mfma_f32_32x32x16_bf16(F[2 * d0 + 1], qr[d0], C1, 0, 0, 0); } }
    if (0 >= tb0 && 0 < tb1) BAND_ADD(0);
    {
#pragma unroll
      for (int r = 0; r < 16; ++r) { C0[r] = EX(C0[r]); C1[r] = EX(C1[r]); }
      pa0 = (u32x4){cvtpk(C0[0], C0[1]), cvtpk(C0[2], C0[3]), cvtpk(C0[4], C0[5]), cvtpk(C0[6], C0[7])}; pa1 = (u32x4){cvtpk(C0[8], C0[9]), cvtpk(C0[10], C0[11]), cvtpk(C0[12], C0[13]), cvtpk(C0[14], C0[15])};
      pa2 = (u32x4){cvtpk(C1[0], C1[1]), cvtpk(C1[2], C1[3]), cvtpk(C1[4], C1[5]), cvtpk(C1[6], C1[7])}; pa3 = (u32x4){cvtpk(C1[8], C1[9]), cvtpk(C1[10], C1[11]), cvtpk(C1[12], C1[13]), cvtpk(C1[14], C1[15])}; }
    WAIT_BAR(4);
    if (c == 0) {
        int t = 1;
#pragma unroll 1
        for (; t + 1 < NT; t += 2) {
            S_H1(t, pa0, pa1, pa2, pa3);     S_H2(t, pa0, pa1, pa2, pa3, pb0, pb1, pb2, pb3);         S_END(t);
            S_H1(t + 1, pb0, pb1, pb2, pb3); S_H2(t + 1, pb0, pb1, pb2, pb3, pa0, pa1, pa2, pa3);     S_END(t + 1);
        }
        S_H1(t, pa0, pa1, pa2, pa3); S_H2(t, pa0, pa1, pa2, pa3, pb0, pb1, pb2, pb3); S_END(t);
    } else {
        S_H1(1, pa0, pa1, pa2, pa3); S_END(1);
        int t = 2;
#pragma unroll 1
        for (; t + 1 < NT; t += 2) {
            S_H2(t - 1, pa0, pa1, pa2, pa3, pb0, pb1, pb2, pb3); S_H1(t, pb0, pb1, pb2, pb3);         S_END(t);
            S_H2(t, pb0, pb1, pb2, pb3, pa0, pa1, pa2, pa3);     S_H1(t + 1, pa0, pa1, pa2, pa3);     S_END(t + 1);
        }
        S_H2(NT - 1, pa0, pa1, pa2, pa3, pb0, pb1, pb2, pb3);
    }
    { float sacc = 0.f;
#pragma unroll
      for (int i_ = 0; i_ < 4; ++i_) { DOT2(pb0[i_]); DOT2(pb1[i_]); DOT2(pb2[i_]); DOT2(pb3[i_]); }
      l_reg += sacc;
      S_LV(NT - 1, 0);
#pragma unroll
      for (int j = 0; j < 8; ++j) { const u32x4 pw_ = (j >> 1) == 0 ? pb0 : (j >> 1) == 1 ? pb1 : (j >> 1) == 2 ? pb2 : pb3; o[j & 1] = __builtin_amdgcn_mfma_f32_32x32x16_bf16(__builtin_bit_cast(bf16x8, pw_), F[j], o[j & 1], 0, 0, 0); }
      S_LV(NT - 1, 2);
#pragma unroll
      for (int j = 0; j < 8; ++j) { const u32x4 pw_ = (j >> 1) == 0 ? pb0 : (j >> 1) == 1 ? pb1 : (j >> 1) == 2 ? pb2 : pb3; o[2 + (j & 1)] = __builtin_amdgcn_mfma_f32_32x32x16_bf16(__builtin_bit_cast(bf16x8, pw_), F[j], o[2 + (j & 1)], 0, 0, 0); } }
#undef S_END
#undef S_H1
#undef S_H2
#undef S_PV
#undef S_PVG
#undef S_QK
#undef S_LV
#undef S_LK
#undef BAND_ADD
#undef DOT2
#undef PIN
#undef EX
#undef SDMA_K
#undef SDMA_V
#undef SDMA_KQ
#undef SDMA_VQ
    {
    const int lane = lane_id_v(), r32 = lane & 31, hi = lane >> 5;
    const float lam = expf(wave_sum(lamp[lane] * lamp[64 + lane])) - expf(wave_sum(lamp[128 + lane] * lamp[192 + lane])) + 0.2f;
    { auto rr = __builtin_amdgcn_permlane32_swap(__float_as_uint(l_reg), __float_as_uint(l_reg), false, false); l_reg = __uint_as_float(rr[0]) + __uint_as_float(rr[1]); }
    if (hi == 0) wsf[r32] = l_reg;
    asm volatile("s_waitcnt lgkmcnt(0)" ::: "memory");
    float rli[16];
#pragma unroll
    for (int r = 0; r < 16; ++r) rli[r] = (c == 0 ? 1.0f : lam) / wsf[crow(r, hi)];
    asm volatile("s_waitcnt lgkmcnt(0)\n\ts_barrier" ::: "memory");
    const lds_fptr stg = (lds_fptr)(shm + qi * D_STG);
    if (c == 1) {
#pragma unroll
        for (int d0 = 0; d0 < 4; ++d0)
#pragma unroll
            for (int r = 0; r < 16; ++r) stg[(d0 * 16 + r) * 64 + lane] = o[d0][r] * rli[r];
    }
    asm volatile("s_waitcnt lgkmcnt(0)\n\ts_barrier" ::: "memory");
    if (c == 0) {
#pragma unroll
        for (int d0 = 0; d0 < 4; ++d0)
#pragma unroll
            for (int r = 0; r < 16; ++r) o[d0][r] = o[d0][r] * rli[r] - stg[(d0 * 16 + r) * 64 + lane];
        asm volatile("s_waitcnt lgkmcnt(0)" ::: "memory");
#pragma unroll
        for (int d0 = 0; d0 < 4; ++d0)
#pragma unroll
            for (int r = 0; r < 16; ++r) stg[crow(r, hi) * 132 + d0 * 32 + r32] = o[d0][r];
        asm volatile("s_waitcnt lgkmcnt(0)" ::: "memory");
        const int row = lane >> 1, half = lane & 1;
        f32x4 v[16]; float ss = 0.f;
#pragma unroll
        for (int i = 0; i < 16; ++i) { v[i] = *(const __attribute__((address_space(3))) f32x4*)(stg + row * 132 + half * 64 + 4 * i); ss += (v[i][0] * v[i][0] + v[i][1] * v[i][1]) + (v[i][2] * v[i][2] + v[i][3] * v[i][3]); }
        ss = xadd<1>(ss);
        const float rn = 1.0f / sqrtf(ss * (1.0f / 128.0f) + EPS);
        bf16_t* Ow = O + (rowbase + q0 + row) * DM + h * 128 + half * 64;
#pragma unroll
        for (int i = 0; i < 8; ++i) { const f32x4 a = v[2 * i] * rn, bq = v[2 * i + 1] * rn;
            u32x4 w = {cvtpk(a[0], a[1]), cvtpk(a[2], a[3]), cvtpk(bq[0], bq[1]), cvtpk(bq[2], bq[3])};
            *(u32x4*)(Ow + 8 * i) = w; }
    }
    }
    asm volatile("s_waitcnt vmcnt(0) lgkmcnt(0)\n\ts_barrier" ::: "memory");
}
constexpr int N_SLOT = 16384, N_NSLOT = 3;
template <int HALF>
__device__ __forceinline__ void n_tile(f32x16 (&o)[2], float& l_reg, const bf16x8 (&qr)[4], lds_cptr kp, lds_cptr vp, lds_fptr tbl, int tb  , int cs, int hi) {
    f32x16 b0, b1;
#pragma unroll
    for (int rr = 0; rr < 16; ++rr) { const int k0 = crow(rr, hi), k1 = k0 + 32;
        const bool live0 = HALF == 0 || rr >= 12, live1 = HALF == 1 || rr < 4;
        if (live0) { const bool v = (unsigned)(k0 - cs) < 16u; const float x = tbl[v ? tb + k0 : 0]; b0[rr] = v ? x : -1e30f; } else b0[rr] = -1e30f;
        if (live1) { const bool v = (unsigned)(k1 - cs) < 16u; const float x = tbl[v ? tb + k1 : 0]; b1[rr] = v ? x : -1e30f; } else b1[rr] = -1e30f; }
    f32x16 p0, p1;
#pragma unroll
    for (int d0 = 0; d0 < 4; ++d0) {
        const bf16x8 k0 = *(const __attribute__((address_space(3))) bf16x8*)(kp + d0 * 2048);
        const bf16x8 k1 = *(const __attribute__((address_space(3))) bf16x8*)(kp + d0 * 2048 + 512);
        if (d0 == 0) { p0 = __builtin_amdgcn_mfma_f32_32x32x16_bf16(k0, qr[0], b0, 0, 0, 0); p1 = __builtin_amdgcn_mfma_f32_32x32x16_bf16(k1, qr[0], b1, 0, 0, 0); }
        else { p0 = __builtin_amdgcn_mfma_f32_32x32x16_bf16(k0, qr[d0], p0, 0, 0, 0); p1 = __builtin_amdgcn_mfma_f32_32x32x16_bf16(k1, qr[d0], p1, 0, 0, 0); }
    }
    float s = 0.f;
#pragma unroll
    for (int rr = 0; rr < 16; ++rr) {
        if (HALF == 0 || rr >= 12) { p0[rr] = __builtin_amdgcn_exp2f(p0[rr]); s += p0[rr]; } else p0[rr] = 0.f;
        if (HALF == 1 || rr < 4) { p1[rr] = __builtin_amdgcn_exp2f(p1[rr]); s += p1[rr]; } else p1[rr] = 0.f; }
    l_reg += s;
    u32x4 pw[4];
    pw[0] = (u32x4){cvtpk(p0[0], p0[1]), cvtpk(p0[2], p0[3]), cvtpk(p0[4], p0[5]), cvtpk(p0[6], p0[7])};
    pw[1] = (u32x4){cvtpk(p0[8], p0[9]), cvtpk(p0[10], p0[11]), cvtpk(p0[12], p0[13]), cvtpk(p0[14], p0[15])};
    pw[2] = (u32x4){cvtpk(p1[0], p1[1]), cvtpk(p1[2], p1[3]), cvtpk(p1[4], p1[5]), cvtpk(p1[6], p1[7])};
    pw[3] = (u32x4){cvtpk(p1[8], p1[9]), cvtpk(p1[10], p1[11]), cvtpk(p1[12], p1[13]), cvtpk(p1[14], p1[15])};
#pragma unroll
    for (int d0 = 0; d0 < 2; ++d0)
#pragma unroll
        for (int ks = (HALF == 0 ? 0 : 1); ks < (HALF == 0 ? 3 : 4); ++ks) {
            const s16x4 lo = vtr(vp + (d0 * 4 + ks) * 1024), hh = vtr(vp + (d0 * 4 + ks) * 1024 + 512);
            const bf16x8 vf = (bf16x8){lo[0], lo[1], lo[2], lo[3], hh[0], hh[1], hh[2], hh[3]};
            o[d0] = __builtin_amdgcn_mfma_f32_32x32x16_bf16(__builtin_bit_cast(bf16x8, pw[ks]), vf, o[d0], 0, 0, 0);
        }
}
template <int NPROBE = 0  >
__device__ __forceinline__ void n_unit(int b, int h, int rg, const bf16_t* Q, const bf16_t* K, const bf16_t* V, bf16_t* O, char* shm, char* aux, const int wave_in) {
    const int lane_ = lane_id_v();
    const int lane = lane_, r32 = lane & 31, hi = lane >> 5;
    const int wid = wave_in, half = wid & 1, r = 4 * rg + (wid >> 1);
    const long rowbase = (long)b * SEQ;
    const lds_fptr tbl = (lds_fptr)aux;
    const int c = 32 * half + r32;
    int rs = r - 4; rs = rs < 0 ? 0 : (rs > 56 ? 56 : rs);
    int cs = c - 8; cs = cs < 0 ? 0 : (cs > 48 ? 48 : cs);
    int kr_lo = 4 * rg - 4; kr_lo = kr_lo < 0 ? 0 : (kr_lo > 56 ? 56 : kr_lo);
    int kr_hi = 4 * rg + 3 - 4; kr_hi = (kr_hi < 0 ? 0 : (kr_hi > 56 ? 56 : kr_hi)) + 7;
    const int nt = kr_hi - kr_lo + 1;
    const unsigned lds0 = (unsigned)(uintptr_t)shm;
    const bf16_t* ksrc = K + (rowbase + kr_lo * 64 + lane) * DM + h * 64 + wid * 8;
    const bf16_t* vsrc = V + (rowbase + kr_lo * 64 + 16 * (wid & 3) + (lane >> 2)) * DM + h * 64 + (wid >> 2) * 32 + (lane & 3) * 8;
    const unsigned dst0 = lds0 + wid * 1024;
#define N_DMA(t, slot) do { const unsigned d_ = (unsigned)__builtin_amdgcn_readfirstlane(dst0 + (slot)); glds16(ksrc + (long)(t) * 64 * DM, d_); glds16(vsrc + (long)(t) * 64 * DM, d_ + 8192); } while (0)
    const bf16_t* Qw = Q + (rowbase + r * 64 + c) * DM + h * 64 + hi * 8;
    bf16x8 qr[4];
#pragma unroll
    for (int d0 = 0; d0 < 4; ++d0) qr[d0] = *(const bf16x8*)(Qw + d0 * 16);
    N_DMA(0, 0); N_DMA(1, N_SLOT);
    const lds_cptr shm3 = (lds_cptr)shm;
    const lds_cptr kp0 = shm3 + hi * 1024 + r32 * 16;
    const lds_cptr vp0 = shm3 + 8192 + ((lane >> 4) & 1) * 32 + (lane & 3) * 8 + (4 * hi + ((lane & 15) >> 2)) * 64;
    f32x16 o[2]; o[0] = f32x16{}; o[1] = f32x16{};
    float l_reg = 0.f;
    int slot = 0;
#pragma unroll 1
    for (int t = 0; t < nt; ++t) {
        if (t + 1 < nt) { WAIT_BAR(2); } else { WAIT_BAR(0); }
        if (t + 2 < nt) { int s2 = slot + 2 * N_SLOT; if (s2 >= N_NSLOT * N_SLOT) s2 -= N_NSLOT * N_SLOT; N_DMA(t + 2, s2); }
        const int kr = kr_lo + t;
        if (!(NPROBE & 1) && kr >= rs && kr < rs + 8) {
            const int tb = (kr - r + 7) * 31 - c + 15;
            if (half == 0) n_tile<0>(o, l_reg, qr, kp0 + slot, vp0 + slot, tbl, tb, cs, hi);
            else           n_tile<1>(o, l_reg, qr, kp0 + slot, vp0 + slot, tbl, tb, cs, hi);
        }
        slot += N_SLOT; if (slot >= N_NSLOT * N_SLOT) slot = 0;
    }
#undef N_DMA
    { auto rr = __builtin_amdgcn_permlane32_swap(__float_as_uint(l_reg), __float_as_uint(l_reg), false, false); l_reg = __uint_as_float(rr[0]) + __uint_as_float(rr[1]); }
    asm volatile("s_waitcnt lgkmcnt(0)\n\ts_barrier" ::: "memory");
    const lds_fptr wsf = (lds_fptr)(shm + wid * 8192);
    if (hi == 0) wsf[r32] = l_reg;
    asm volatile("s_waitcnt lgkmcnt(0)" ::: "memory");
    float rli[16];
#pragma unroll
    for (int rr = 0; rr < 16; ++rr) rli[rr] = 1.0f / wsf[crow(rr, hi)];
    asm volatile("s_waitcnt lgkmcnt(0)" ::: "memory");
    __attribute__((address_space(3))) unsigned short* stg = (__attribute__((address_space(3))) unsigned short*)(shm + wid * 8192 + 1024);
#pragma unroll
    for (int rr = 0; rr < 16; ++rr) { const int orow = crow(rr, hi);
#pragma unroll
        for (int d0 = 0; d0 < 2; ++d0) stg[orow * 64 + d0 * 32 + r32] = (unsigned short)(cvtpk(o[d0][rr] * rli[rr], 0.f) & 0xffffu); }
    asm volatile("s_waitcnt lgkmcnt(0)" ::: "memory");
    bf16_t* Ow = O + (rowbase + r * 64 + 32 * half) * DM + h * 64;
#pragma unroll
    for (int i = 0; i < 4; ++i) { const int row = i * 8 + (lane >> 3), ch = lane & 7;
        const u32x4 v = *(const __attribute__((address_space(3))) u32x4*)(stg + row * 64 + ch * 8);
        *(u32x4*)(Ow + (long)row * DM + ch * 8) = v; }
    asm volatile("s_waitcnt vmcnt(0) lgkmcnt(0)\n\ts_barrier" ::: "memory");
}
template <int NPROBE = 0>
__device__ __forceinline__ void n_unit8(int b, int h, int rg8, const bf16_t* Q, const bf16_t* K, const bf16_t* V, bf16_t* O, char* shm, char* aux, const int wave_in) {
    const int lane_ = lane_id_v();
    const int lane = lane_, r32 = lane & 31, hi = lane >> 5;
    const int wid = wave_in, r = 8 * rg8 + wid;
    const long rowbase = (long)b * SEQ;
    const lds_fptr tbl = (lds_fptr)aux;
    int rs = r - 4; rs = rs < 0 ? 0 : (rs > 56 ? 56 : rs);
    const int c0 = r32, c1 = 32 + r32;
    int cs0 = c0 - 8; cs0 = cs0 < 0 ? 0 : cs0;
    int cs1 = c1 - 8; cs1 = cs1 > 48 ? 48 : cs1;
    int kr_lo = 8 * rg8 - 4; kr_lo = kr_lo < 0 ? 0 : (kr_lo > 56 ? 56 : kr_lo);
    int kr_hi = 8 * rg8 + 7 - 4; kr_hi = (kr_hi < 0 ? 0 : (kr_hi > 56 ? 56 : kr_hi)) + 7;
    const int nt = kr_hi - kr_lo + 1;
    const unsigned lds0 = (unsigned)(uintptr_t)shm;
    const bf16_t* ksrc = K + (rowbase + kr_lo * 64 + lane) * DM + h * 64 + wid * 8;
    const bf16_t* vsrc = V + (rowbase + kr_lo * 64 + 16 * (wid & 3) + (lane >> 2)) * DM + h * 64 + (wid >> 2) * 32 + (lane & 3) * 8;
    const unsigned dst0 = lds0 + wid * 1024;
#define N_DMA(t, slot) do { const unsigned d_ = (unsigned)__builtin_amdgcn_readfirstlane(dst0 + (slot)); glds16(ksrc + (long)(t) * 64 * DM, d_); glds16(vsrc + (long)(t) * 64 * DM, d_ + 8192); } while (0)
    const bf16_t* Qw = Q + (rowbase + r * 64 + r32) * DM + h * 64 + hi * 8;
    bf16x8 qa[4], qb[4];
#pragma unroll
    for (int d0 = 0; d0 < 4; ++d0) { qa[d0] = *(const bf16x8*)(Qw + d0 * 16); qb[d0] = *(const bf16x8*)(Qw + 32 * DM + d0 * 16); }
    N_DMA(0, 0); N_DMA(1, N_SLOT);
    const lds_cptr shm3 = (lds_cptr)shm;
    const lds_cptr kp0 = shm3 + hi * 1024 + r32 * 16;
    const lds_cptr vp0 = shm3 + 8192 + ((lane >> 4) & 1) * 32 + (lane & 3) * 8 + (4 * hi + ((lane & 15) >> 2)) * 64;
    f32x16 oa[2], ob[2]; oa[0] = f32x16{}; oa[1] = f32x16{}; ob[0] = f32x16{}; ob[1] = f32x16{};
    float la = 0.f, lb = 0.f;
    int slot = 0;
#pragma unroll 1
    for (int t = 0; t < nt; ++t) {
        if (t + 1 < nt) { WAIT_BAR(2); } else { WAIT_BAR(0); }
        if (t + 2 < nt) { int s2 = slot + 2 * N_SLOT; if (s2 >= N_NSLOT * N_SLOT) s2 -= N_NSLOT * N_SLOT; N_DMA(t + 2, s2); }
        const int kr = kr_lo + t;
        if (!(NPROBE & 1) && kr >= rs && kr < rs + 8) {
            const int tbr = (kr - r + 7) * 31 + 15;
            n_tile<0>(oa, la, qa, kp0 + slot, vp0 + slot, tbl, tbr - c0, cs0, hi);
            n_tile<1>(ob, lb, qb, kp0 + slot, vp0 + slot, tbl, tbr - c1, cs1, hi);
        }
        slot += N_SLOT; if (slot >= N_NSLOT * N_SLOT) slot = 0;
    }
#undef N_DMA
    asm volatile("s_waitcnt lgkmcnt(0)\n\ts_barrier" ::: "memory");
    const lds_fptr wsf = (lds_fptr)(shm + wid * 8192);
    __attribute__((address_space(3))) unsigned short* stg = (__attribute__((address_space(3))) unsigned short*)(shm + wid * 8192 + 1024);
#pragma unroll
    for (int hf = 0; hf < 2; ++hf) {
        float l_reg = hf == 0 ? la : lb;
        { auto rr = __builtin_amdgcn_permlane32_swap(__float_as_uint(l_reg), __float_as_uint(l_reg), false, false); l_reg = __uint_as_float(rr[0]) + __uint_as_float(rr[1]); }
        if (hi == 0) wsf[r32] = l_reg;
        asm volatile("s_waitcnt lgkmcnt(0)" ::: "memory");
        float rli[16];
#pragma unroll
        for (int rr = 0; rr < 16; ++rr) rli[rr] = 1.0f / wsf[crow(rr, hi)];
        asm volatile("s_waitcnt lgkmcnt(0)" ::: "memory");
#pragma unroll
        for (int rr = 0; rr < 16; ++rr) { const int orow = crow(rr, hi);
#pragma unroll
            for (int d0 = 0; d0 < 2; ++d0) stg[orow * 64 + d0 * 32 + r32] = (unsigned short)(cvtpk((hf == 0 ? oa[d0][rr] : ob[d0][rr]) * rli[rr], 0.f) & 0xffffu); }
        asm volatile("s_waitcnt lgkmcnt(0)" ::: "memory");
        bf16_t* Ow = O + (rowbase + r * 64 + 32 * hf) * DM + h * 64;
#pragma unroll
        for (int i = 0; i < 4; ++i) { const int row = i * 8 + (lane >> 3), ch = lane & 7;
            const u32x4 v = *(const __attribute__((address_space(3))) u32x4*)(stg + row * 64 + ch * 8);
            *(u32x4*)(Ow + (long)row * DM + ch * 8) = v; }
        asm volatile("s_waitcnt lgkmcnt(0)" ::: "memory");
    }
    asm volatile("s_waitcnt vmcnt(0) lgkmcnt(0)\n\ts_barrier" ::: "memory");
}
#undef SBAR
#undef WAIT_BAR
}
#define GAS __attribute__((address_space(1)))
#define LAS __attribute__((address_space(3)))
typedef unsigned short bf16;
typedef unsigned v4u __attribute__((ext_vector_type(4)));
typedef float f32x4 __attribute__((ext_vector_type(4)));
typedef short bf16x8 __attribute__((ext_vector_type(8)));
typedef GAS unsigned gu32;
typedef GAS unsigned long long gu64;
#define RLX_AGENT __ATOMIC_RELAXED, __HIP_MEMORY_SCOPE_AGENT
#define LDS_WAIT() asm volatile("s_waitcnt lgkmcnt(0)" ::: "memory")
#define VM_WAIT() asm volatile("s_waitcnt vmcnt(0)" ::: "memory")
__device__ __forceinline__ unsigned long long rt() { return __builtin_amdgcn_s_memrealtime(); }
__device__ __forceinline__ unsigned f2bf(float f) { unsigned u = __builtin_bit_cast(unsigned, f); return (u + 0x7fffu + ((u >> 16) & 1u)) >> 16; }
__device__ __forceinline__ unsigned pk2(float lo, float hi) { return f2bf(lo) | (f2bf(hi) << 16); }

#define XB_TMO      128
#define XB_XCNT(j)  (256  + 64 * (j))
#define XB_XSUB(j)  (1280 + 64 * (j))
#define XB_XGEN(j)  (2304 + 64 * (j))
#define XB_TOP      3328
#define XB_TOPGEN   3392
#define XCD_BAR_WORDS 3456
#define XB_SPIN_CAP (1u << 18)

__device__ __forceinline__ unsigned xb_ld(unsigned* p)              { return __hip_atomic_load(p, __ATOMIC_RELAXED, __HIP_MEMORY_SCOPE_AGENT); }
__device__ __forceinline__ unsigned xb_add(unsigned* p, unsigned v) { return __hip_atomic_fetch_add(p, v, __ATOMIC_RELAXED, __HIP_MEMORY_SCOPE_AGENT); }
__device__ __forceinline__ unsigned xb_xcc_id() { return (unsigned)__builtin_amdgcn_s_getreg((3 << 11) | 20) & 0xFu; }
#define XB_SPIN(cond, bar) do { unsigned _sp = 0; while (cond) { __builtin_amdgcn_s_sleep(1); \
    if ((++_sp & 255u) == 0u) { if (xb_ld(&(bar)[XB_TMO])) break; if (_sp > XB_SPIN_CAP) { atomicAdd(&(bar)[XB_TMO], 1u); break; } } } } while (0)

struct XcdBarrier {
    unsigned* bar; unsigned x;
    volatile LAS unsigned* st;
};

__device__ __forceinline__ XcdBarrier xcd_barrier_post(unsigned* bar, volatile LAS unsigned* st, const bool leader) {
    XcdBarrier b; b.bar = bar; b.x = xb_xcc_id(); b.st = st;
    if (leader) (void)xb_add(&bar[XB_XCNT(b.x)], 1u);
    return b;
}
__device__ __forceinline__ void xcd_barrier_complete(unsigned* bar, unsigned x, unsigned& nloc, unsigned& nx) {
    const unsigned G = gridDim.x * gridDim.y * gridDim.z;
    unsigned sum, cnt, mine, sp = 0u;
    for (;;) {
        sum = 0u; cnt = 0u; mine = 0u;
#pragma unroll
        for (unsigned j = 0; j < 16; ++j) { const unsigned c = xb_ld(&bar[XB_XCNT(j)]); sum += c; cnt += (c > 0u) ? 1u : 0u; mine = (j == x) ? c : mine; }
        if (sum == G) break;
        __builtin_amdgcn_s_sleep(1);
        if ((++sp & 255u) == 0u) { if (xb_ld(&bar[XB_TMO])) break; if (sp > XB_SPIN_CAP) { atomicAdd(&bar[XB_TMO], 1u); break; } }
    }
    nloc = mine > 0u ? mine : 1u; nx = cnt > 0u ? cnt : 1u;
}

__device__ __forceinline__ void xcd_barrier(const XcdBarrier& b, const bool leader) {
    asm volatile("s_waitcnt vmcnt(0)" ::: "memory");
    __syncthreads();
    if (leader) {
        unsigned* bar = b.bar;
        __builtin_amdgcn_s_waitcnt(0);
        unsigned nloc = b.st[0], nx = b.st[1];
        if (nloc == 0u) { xcd_barrier_complete(bar, b.x, nloc, nx); b.st[0] = nloc; b.st[1] = nx; }
        const unsigned old = xb_add(&bar[XB_XSUB(b.x)], 1u);
        const unsigned gen = old / nloc;
        if (old + 1u == (gen + 1u) * nloc) {
            __builtin_amdgcn_fence(__ATOMIC_RELEASE, "agent");
            asm volatile("s_waitcnt vmcnt(0)" ::: "memory");
            const unsigned og = xb_add(&bar[XB_TOP], 1u);
            const unsigned tg = og / nx;
            if (og + 1u == (tg + 1u) * nx) xb_add(&bar[XB_TOPGEN], 1u);
            else XB_SPIN(xb_ld(&bar[XB_TOPGEN]) == tg, bar);
            __builtin_amdgcn_fence(__ATOMIC_ACQUIRE, "agent");
            xb_add(&bar[XB_XGEN(b.x)], 1u);
            asm volatile("s_waitcnt vmcnt(0)" ::: "memory");
        } else {
            XB_SPIN(xb_ld(&bar[XB_XGEN(b.x)]) == gen, bar);
            __builtin_amdgcn_fence(__ATOMIC_ACQUIRE, "agent");
            asm volatile("s_waitcnt vmcnt(0)" ::: "memory");
        }
    }
    __syncthreads();
}
constexpr int NWAVES = 8;
constexpr int BATCH = 4, SEQ = 4096, DMODEL = 1024, M = BATCH * SEQ, DFF = 2816, PLE = 256, DEPTH = 2;
constexpr size_t MiB = 1u << 20;
constexpr size_t WS_CTL = 0, CTL_ZERO_BYTES = 1 * MiB;
constexpr size_t SZ_WFI = (size_t)2 * DFF * DMODEL * 2, SZ_WFO = (size_t)DMODEL * DFF * 2, SZ_WQKV = (size_t)3 * DMODEL * DMODEL * 2, SZ_WSQ = (size_t)DMODEL * DMODEL * 2, SZ_WP = (size_t)DMODEL * PLE * 2;
constexpr size_t WS_WFI = 1 * MiB;
constexpr size_t WS_WFO = WS_WFI + 4 * SZ_WFI;
constexpr size_t WS_WQKV = WS_WFO + 4 * SZ_WFO;
constexpr size_t WS_WO = WS_WQKV + 2 * SZ_WQKV;
constexpr size_t WS_WG = WS_WO + 2 * SZ_WSQ;
constexpr size_t WS_WP = WS_WG + 2 * SZ_WSQ;
constexpr size_t WS_WEND = WS_WP + 2 * SZ_WP;
constexpr size_t SZ_ACT = (size_t)M * DMODEL * 2;
constexpr size_t WS_HBA = (WS_WEND + 4095) / 4096 * 4096;
constexpr size_t WS_OB = WS_HBA + SZ_ACT;
constexpr size_t WS_SSPA = WS_OB + SZ_ACT, WS_SSPB = WS_SSPA + (size_t)M * 64;
constexpr size_t WS_QKV = WS_SSPB + (size_t)M * 64;
constexpr size_t WS_HID = WS_QKV;
constexpr size_t WS_PB = WS_QKV + 3 * SZ_ACT;
constexpr size_t WS_PROJ = WS_PB + (size_t)2 * M * PLE * 2;
constexpr size_t WS_END = WS_PROJ + SZ_ACT;
static_assert((size_t)M * DFF * 2 <= 3 * SZ_ACT, "hid fits the Q|K|V region");
constexpr int CW_TMO = 0, CW_BAR = 4096;
constexpr int LDS_BYTES_ = 147456;
constexpr int RING_OFF = 0, RING_BYTES = 131072, LDSCTL_OFF = LDS_BYTES_ - 4096  , MISC_OFF = LDSCTL_OFF + 320, PT_OFF = LDSCTL_OFF + 512  , AUX_OFF = LDSCTL_OFF + 1024  , LDS_BYTES = 147456;
static_assert(8 * 16640 <= LDSCTL_OFF && LDS_BYTES == LDS_BYTES_ && AUX_OFF + 3072 <= LDS_BYTES && att::D_NSLOT * att::D_SLOT <= RING_BYTES && att::S_VBASE + att::S_NV * att::S_VSLOT <= RING_BYTES && 4 * att::D_STG <= RING_BYTES, "LDS map");

struct Args {
    const float* in[20]; float* out; unsigned char* ws;
    int ph_lo, ph_hi, li, x_in_out, hb_sel, pad;
};
struct Frame {
    LAS unsigned char* lds; volatile LAS unsigned* MISC; gu32* ctl;
    int tid, lane, wave, vcu, G;
};
__device__ __forceinline__ float wave_sum64(float v) { return wsum64(v); }
__device__ __forceinline__ const void* ldp(LAS unsigned char* lds, int k) {
    const unsigned long long v = *(volatile LAS unsigned long long*)(lds + PT_OFF + 8 * k);
    const unsigned lo = (unsigned)__builtin_amdgcn_readfirstlane((int)(unsigned)v), hi = (unsigned)__builtin_amdgcn_readfirstlane((int)(unsigned)(v >> 32));
    return (const void*)(const GAS char*)(uintptr_t)(((unsigned long long)hi << 32) | lo);
}
#define INP(k) ((const float*)ldp(F.lds, (k)))
template <int MAP> __device__ __forceinline__ int dest_row(int n0) {
    if (MAP == 1) { const int isu = n0 >= DFF, j0 = isu ? n0 - DFF : n0; return 256 * (j0 >> 7) + 128 * isu + (j0 & 127); }
    if (MAP == 2) { const int pn = n0 >> 8, rem = n0 & 255; return 256 * pn + 128 * ((rem & 63) >> 5) + 32 * (rem >> 6); }
    return n0;
}
template <int MAP> __device__ __forceinline__ void p0_matrix_np(const int gw, const int NGW, const int lane, const float* W, int K, int N, bf16* WT, const float* ksc, int kmask, float kmul, LAS float* scr) {
    const int nblk = N / 64, nitems = (K / 64) * nblk;
    const int lr = lane >> 4, lc = 4 * (lane & 15);
    for (int it = gw; it < nitems; it += NGW) {
        const int k0 = 64 * (it / nblk), n0 = 64 * (it % nblk);
        f32x4 v[16];
#pragma unroll
        for (int i = 0; i < 16; ++i) v[i] = __builtin_nontemporal_load((const GAS f32x4*)(W + (size_t)(k0 + 4 * i + lr) * N + n0 + lc));
#pragma unroll
        for (int i = 0; i < 16; ++i) { const int kk = 4 * i + lr; const float sc = ksc ? ksc[(k0 + kk) & kmask] * kmul : 1.0f;
            LAS float* d = scr + kk * 65 + lc; d[0] = v[i].x * sc; d[1] = v[i].y * sc; d[2] = v[i].z * sc; d[3] = v[i].w * sc; }
        LDS_WAIT(); asm volatile("" ::: "memory");
        const int c = lane & 7;
#pragma unroll
        for (int j = 0; j < 8; ++j) { const int n = (lane >> 3) + 8 * j; const LAS float* s = scr + (8 * c) * 65 + n;
            v4u o; o.x = pk2(s[0 * 65], s[1 * 65]); o.y = pk2(s[2 * 65], s[3 * 65]); o.z = pk2(s[4 * 65], s[5 * 65]); o.w = pk2(s[6 * 65], s[7 * 65]);
            *(GAS v4u*)(WT + (size_t)(dest_row<MAP>(n0 + (n & 32)) + (n & 31)) * K + k0 + 8 * c) = o; }
        LDS_WAIT(); asm volatile("" ::: "memory");
    }
}
template <int MAP> __device__ __forceinline__ void p0_matrix(const int gw, const int NGW, const int lane, const float* W, int K, int N, bf16* WT, const float* ksc, int kmask, float kmul, LAS float* scr) {
    const int nblk = N / 64, nitems = (K / 64) * nblk;
    const int lr = lane >> 4, lc = 4 * (lane & 15), c = lane & 7;
#define PM_LOAD(V, SC, IT) do { const int k0_ = 64 * ((IT) / nblk), n0_ = 64 * ((IT) % nblk); \
        _Pragma("unroll") for (int i = 0; i < 16; ++i) V[i] = __builtin_nontemporal_load((const GAS f32x4*)(W + (size_t)(k0_ + 4 * i + lr) * N + n0_ + lc)); \
        _Pragma("unroll") for (int i = 0; i < 16; ++i) SC[i] = ksc ? ksc[(k0_ + 4 * i + lr) & kmask] * kmul : 1.0f; } while (0)
#define PM_PROC(V, SC, IT) do { const int k0_ = 64 * ((IT) / nblk), n0_ = 64 * ((IT) % nblk); \
        _Pragma("unroll") for (int i = 0; i < 16; ++i) { LAS float* d = scr + (4 * i + lr) * 65 + lc; const float sc = SC[i]; d[0] = V[i].x * sc; d[1] = V[i].y * sc; d[2] = V[i].z * sc; d[3] = V[i].w * sc; } \
        LDS_WAIT(); asm volatile("" ::: "memory"); \
        _Pragma("unroll") for (int j = 0; j < 8; ++j) { const int n = (lane >> 3) + 8 * j; const LAS float* s_ = scr + (8 * c) * 65 + n; \
            v4u o; o.x = pk2(s_[0 * 65], s_[1 * 65]); o.y = pk2(s_[2 * 65], s_[3 * 65]); o.z = pk2(s_[4 * 65], s_[5 * 65]); o.w = pk2(s_[6 * 65], s_[7 * 65]); \
            *(GAS v4u*)(WT + (size_t)(dest_row<MAP>(n0_ + (n & 32)) + (n & 31)) * K + k0_ + 8 * c) = o; } \
        LDS_WAIT(); asm volatile("" ::: "memory"); } while (0)
    int it = gw; if (it >= nitems) return;
    f32x4 va[16], vb[16]; float sa[16], sb[16];
    PM_LOAD(va, sa, it);
    while (true) {
        const int it1 = it + NGW; if (it1 < nitems) PM_LOAD(vb, sb, it1);
        PM_PROC(va, sa, it);
        if (it1 >= nitems) break;
        const int it2 = it1 + NGW; if (it2 < nitems) PM_LOAD(va, sa, it2);
        PM_PROC(vb, sb, it1);
        if (it2 >= nitems) break;
        it = it2;
    }
#undef PM_LOAD
#undef PM_PROC
}
#ifndef MK_WGM_FFN
#define MK_WGM_FFN 4
#endif
#ifndef MK_WGM_QKV
#define MK_WGM_QKV 4
#endif
#ifndef MK_WGM_N1K
#define MK_WGM_N1K 4
#endif
#ifndef MK_ALIGN1
#define MK_ALIGN1 true
#endif
#ifndef MK_SP2
#define MK_SP2 true
#endif
#ifndef MK_CONV_PROBE
#define MK_CONV_PROBE 0
#endif
#ifndef MK_FILL
#define MK_FILL 1
#endif
#ifndef MK_CONV_START
#define MK_CONV_START 1
#endif
#ifndef MK_FILL_WAVES
#define MK_FILL_WAVES 4
#endif
#ifndef MK_CONV_PIPE
#define MK_CONV_PIPE 1
#endif
template <int MAP, int SET> __device__ __forceinline__ void pmx(const int gw, const int NGW, const int lane, const float* W, int K, int N, bf16* WT, const float* ksc, int kmask, float kmul, LAS float* scr) {
    if (MK_CONV_PIPE & (SET == 0 ? 1 : 2)) p0_matrix<MAP>(gw, NGW, lane, W, K, N, WT, ksc, kmask, kmul, scr); else p0_matrix_np<MAP>(gw, NGW, lane, W, K, N, WT, ksc, kmask, kmul, scr);
}
template <int SET> __device__ __forceinline__ void conv_weights(Frame& F, const int gw, const int NGW) {
    unsigned char* ws = (unsigned char*)ldp(F.lds, 21);
    LAS float* scr = (LAS float*)(F.lds + RING_OFF + F.wave * 16640);
    const float* ng = INP(2); const int lane = lane_id_v();
#define CV_WFI(i) pmx<1, SET>(gw, NGW, lane, INP(3) + (size_t)(i) * DMODEL * 2 * DFF, DMODEL, 2 * DFF, (bf16*)(ws + WS_WFI + (i) * SZ_WFI), ng + (((i) >> 1) * 4 + ((i) & 1) * 2) * DMODEL, 1023, 1.0f, scr)
#define CV_WFO(i) pmx<0, SET>(gw, NGW, lane, INP(4) + (size_t)(i) * DFF * DMODEL, DFF, DMODEL, (bf16*)(ws + WS_WFO + (i) * SZ_WFO), nullptr, 0, 1.0f, scr)
#define CV_WG(l)  pmx<0, SET>(gw, NGW, lane, INP(17) + (size_t)(l) * DMODEL * DMODEL, DMODEL, DMODEL, (bf16*)(ws + WS_WG + (l) * SZ_WSQ), ng + ((l) * 4 + 3) * DMODEL, 1023, 1.0f, scr)
#define CV_WP(l)  pmx<0, SET>(gw, NGW, lane, INP(19) + (size_t)(l) * PLE * DMODEL, PLE, DMODEL, (bf16*)(ws + WS_WP + (l) * SZ_WP), nullptr, 0, 1.0f, scr)
    if (SET == 0) { CV_WFI(0); CV_WP(0);
    } else if (SET == 1) {
        CV_WFO(0);
        pmx<2, SET>(gw, NGW, lane, INP(6), DMODEL, 3 * DMODEL, (bf16*)(ws + WS_WQKV), ng + 1 * DMODEL, 1023, 1.0f, scr);
        pmx<0, SET>(gw, NGW, lane, INP(7), DMODEL, DMODEL, (bf16*)(ws + WS_WO), INP(11), 127, 0.8f, scr);
        CV_WFI(1);
    } else if (SET == 2) { CV_WFO(1); CV_WG(0); CV_WFI(2);
    } else if (SET == 3) {
        CV_WFO(2);
        pmx<2, SET>(gw, NGW, lane, INP(12), DMODEL, 3 * DMODEL, (bf16*)(ws + WS_WQKV + SZ_WQKV), ng + 5 * DMODEL, 1023, 1.0f, scr);
        pmx<0, SET>(gw, NGW, lane, INP(13), DMODEL, DMODEL, (bf16*)(ws + WS_WO + SZ_WSQ), nullptr, 0, 1.0f, scr);
        CV_WFI(3); CV_WP(1);
    } else { CV_WFO(3); CV_WG(1); }
#undef CV_WFI
#undef CV_WFO
#undef CV_WG
#undef CV_WP
}
__device__ __forceinline__ void conv_p(Frame& F, const int l, const int gw, const int NGW) {
    const size_t n4 = (size_t)M * PLE / 4; const GAS f32x4* p4 = (const GAS f32x4*)INP(1) + (size_t)l * n4; GAS unsigned long long* o8 = (GAS unsigned long long*)((unsigned char*)ldp(F.lds, 21) + WS_PB) + (size_t)l * n4;
    const int lane = lane_id_v();
    for (size_t i = (size_t)gw * 256 + lane; i < n4; i += (size_t)NGW * 256) { f32x4 v[4];
#pragma unroll
        for (int j = 0; j < 4; ++j) v[j] = __builtin_nontemporal_load(p4 + i + 64 * j);
#pragma unroll
        for (int j = 0; j < 4; ++j) o8[i + 64 * j] = (unsigned long long)pk2(v[j].x, v[j].y) | ((unsigned long long)pk2(v[j].z, v[j].w) << 32); }
}
__device__ __forceinline__ void p0_prologue(Frame& F, const Args& a) {
    unsigned char* ws = a.ws;
    const int gw = F.vcu * NWAVES + F.wave, NGW = F.G * NWAVES;
    const float* h0 = a.x_in_out ? a.out : a.in[0];
    bf16* hbB = (bf16*)(ws + (a.hb_sel ? WS_HBA : WS_OB)); float* sspB = (float*)(ws + (a.hb_sel ? WS_SSPA : WS_SSPB));
    for (int m = 2 * gw; m < M; m += 2 * NGW) {
        f32x4 v[2][4]; float s[2];
#pragma unroll
        for (int rr = 0; rr < 2; ++rr) { const GAS f32x4* xr = (const GAS f32x4*)(h0 + (size_t)(m + rr) * DMODEL) + F.lane;
#pragma unroll
            for (int j = 0; j < 4; ++j) v[rr][j] = __builtin_nontemporal_load(xr + 64 * j); }
#pragma unroll
        for (int rr = 0; rr < 2; ++rr) { float t = 0.f;
#pragma unroll
            for (int j = 0; j < 4; ++j) t += (v[rr][j].x * v[rr][j].x + v[rr][j].y * v[rr][j].y) + (v[rr][j].z * v[rr][j].z + v[rr][j].w * v[rr][j].w);
            s[rr] = wave_sum64(t);
            GAS unsigned long long* o8 = (GAS unsigned long long*)(hbB + (size_t)(m + rr) * DMODEL) + F.lane;
#pragma unroll
            for (int j = 0; j < 4; ++j) o8[64 * j] = (unsigned long long)pk2(v[rr][j].x, v[rr][j].y) | ((unsigned long long)pk2(v[rr][j].z, v[rr][j].w) << 32);
            if (F.lane < 16) sspB[(size_t)(m + rr) * 16 + F.lane] = F.lane == 0 ? s[rr] : 0.f; }
    }
    conv_p(F, 0, gw, NGW); if (!MK_FILL || MK_CONV_PROBE) conv_p(F, 1, gw, NGW);
    conv_weights<0>(F, gw, NGW);
    if (!MK_FILL || MK_CONV_PROBE) { conv_weights<1>(F, gw, NGW); conv_weights<2>(F, gw, NGW); conv_weights<3>(F, gw, NGW); conv_weights<4>(F, gw, NGW); }
}

#ifndef MK_KIND_MASK
#define MK_KIND_MASK 0x1ff
#endif
#ifndef MK_ATT_STAG
#define MK_ATT_STAG 0
#endif
#ifndef MK_NA_PROBE
#define MK_NA_PROBE 0
#endif
#ifndef MK_ATT_PROBE
#define MK_ATT_PROBE 0
#endif
#ifndef MK_ATT_SEL
#define MK_ATT_SEL 3
#endif
#ifndef MK_PLE_SEL
#define MK_PLE_SEL (MK_FILL ? 2 : 3)
#endif
#ifndef MK_REP
#define MK_REP 0
#endif
#define NREP(kind) ((((MK_REP) >> (kind)) & 1) ? 2 : 1)
#ifndef MK_REPNULL
#define MK_REPNULL 0
#endif
#define NNULL(kind) (((MK_REPNULL) >> (kind)) & 1)
struct Ctl { int lo, hi, li, x_in_out; };
#define IN(k) (C.lo <= (k) && (k) < C.hi)
#define INK(kind, k) ((((MK_KIND_MASK) >> (kind)) & 1) && IN(k))
#define SEAM(k) do { if (IN(k) && IN((k) + 1)) { int w_ = F.wave; asm volatile("" : "+s"(w_)); XcdBarrier b_; b_.bar = (unsigned*)(WSB + WS_CTL) + CW_BAR + C.li * XCD_BAR_WORDS; b_.x = xb_xcc_id(); b_.st = F.MISC + 8; \
        xcd_barrier(b_, w_ == 0 && lane_id_v() == 0); if (NREP(9) == 2) xcd_barrier(b_, w_ == 0 && lane_id_v() == 0); } } while (0)
#define WSB ((unsigned char*)ldp(F.lds, 21))
#define HOUT ((float*)ldp(F.lds, 20))
#define RING (F.lds + RING_OFF)
#define RSL ((LAS float*)(F.lds + RING_BYTES))
template <int l, int f> __device__ __forceinline__ void ph_ffn(Frame& F, const Ctl& C) {
    constexpr int pb = 1 + 8 * l, pf = pb + (f == 0 ? 0 : 5);
    if (INK(0, pf)) {
        unsigned char* ws = WSB;
        pg8::Gemm g{(bf16*)(ws + (f == 0 ? WS_OB : WS_HBA)), (bf16*)(ws + WS_WFI + (l * 2 + f) * SZ_WFI), M, 2 * DFF, DMODEL}; pg8::StaticOrder S; S.init(M, 2 * DFF, F.G, (int)blockIdx.x, MK_WGM_FFN);
        pg8::fill_rstd_table(RSL, (float*)(ws + (f == 0 ? WS_SSPB : WS_SSPA)), S, F.wave, lane_id_v(), 6); asm volatile("s_waitcnt lgkmcnt(0)" ::: "memory"); __syncthreads();
        pg8::EpiSwiGLU E{(bf16*)(ws + WS_HID), RSL};
        if (NNULL(0)) { pg8::EpiNull EN; pg8::gemm_phase<pg8::EpiNull, pg8::StaticOrder, true, MK_SP2>(RING, g, S, EN, F.wave); }
        if (MK_CONV_START && MK_FILL && (int)blockIdx.x >= 128) {
            if (l == 0 && f == 0 && !(MK_CONV_PROBE & (2 << 1))) { if (F.wave < MK_FILL_WAVES) conv_weights<1>(F, ((int)blockIdx.x - 128) * MK_FILL_WAVES + F.wave, 128 * MK_FILL_WAVES); }
            if (l == 0 && f == 1 && !(MK_CONV_PROBE & (2 << 2))) { if (F.wave < MK_FILL_WAVES) conv_weights<2>(F, ((int)blockIdx.x - 128) * MK_FILL_WAVES + F.wave, 128 * MK_FILL_WAVES); }
            if (l == 1 && f == 0 && !(MK_CONV_PROBE & (2 << 3))) { if (F.wave < MK_FILL_WAVES) conv_weights<3>(F, ((int)blockIdx.x - 128) * MK_FILL_WAVES + F.wave, 128 * MK_FILL_WAVES); }
            if (l == 1 && f == 1 && !(MK_CONV_PROBE & (2 << 4))) { if (F.wave < MK_FILL_WAVES) conv_weights<4>(F, ((int)blockIdx.x - 128) * MK_FILL_WAVES + F.wave, 128 * MK_FILL_WAVES); }
            asm volatile("s_waitcnt vmcnt(0) lgkmcnt(0)" ::: "memory"); __syncthreads(); }
#pragma unroll 1
        for (int rep = 0; rep < NREP(0); ++rep) pg8::gemm_phase<pg8::EpiSwiGLU, pg8::StaticOrder, true, MK_SP2>(RING, g, S, E, F.wave);
        if (MK_FILL && (int)blockIdx.x >= 128) {
            const int c2 = (int)blockIdx.x - 128;
            if (l == 0 && f == 1 && !(MK_CONV_PROBE & 2)) conv_p(F, 1, c2 * NWAVES + F.wave, 128 * NWAVES);
            if ((l == 0 && f == 0) || (l == 1 && f == 1)) {
                pg8::Gemm g2{(bf16*)(ws + WS_PB) + (size_t)l * M * PLE, (bf16*)(ws + WS_WP + l * SZ_WP), M, DMODEL, PLE}; pg8::PairOrder S2; S2.c2 = c2;
                pg8::EpiPlainBf16 E2{(bf16*)(ws + WS_PROJ), DMODEL};
                pg8::gemm_phase<pg8::EpiPlainBf16, pg8::PairOrder, true, MK_SP2>(RING, g2, S2, E2, F.wave); }
            if (!MK_CONV_START && l == 0 && f == 0 && !(MK_CONV_PROBE & (2 << 1))) { if (F.wave < MK_FILL_WAVES) conv_weights<1>(F, c2 * MK_FILL_WAVES + F.wave, 128 * MK_FILL_WAVES); }
            if (!MK_CONV_START && l == 0 && f == 1 && !(MK_CONV_PROBE & (2 << 2))) { if (F.wave < MK_FILL_WAVES) conv_weights<2>(F, c2 * MK_FILL_WAVES + F.wave, 128 * MK_FILL_WAVES); }
            if (!MK_CONV_START && l == 1 && f == 0 && !(MK_CONV_PROBE & (2 << 3))) { if (F.wave < MK_FILL_WAVES) conv_weights<3>(F, c2 * MK_FILL_WAVES + F.wave, 128 * MK_FILL_WAVES); }
            if (!MK_CONV_START && l == 1 && f == 1 && !(MK_CONV_PROBE & (2 << 4))) { if (F.wave < MK_FILL_WAVES) conv_weights<4>(F, c2 * MK_FILL_WAVES + F.wave, 128 * MK_FILL_WAVES); }
        }
    }
    SEAM(pf);
    if (INK(1, pf + 1)) {
        unsigned char* ws = WSB; float* hout = HOUT;
        pg8::Gemm g{(bf16*)(ws + WS_HID), (bf16*)(ws + WS_WFO + (l * 2 + f) * SZ_WFO), M, DMODEL, DFF}; pg8::StaticOrder S; S.init(M, DMODEL, F.G, (int)blockIdx.x, MK_WGM_N1K);
        if (NNULL(1)) { pg8::EpiNull EN; pg8::gemm_phase<pg8::EpiNull, pg8::StaticOrder, true, MK_SP2>(RING, g, S, EN, F.wave); }
#pragma unroll 1
        for (int rep = 0; rep < NREP(1); ++rep) {
        pg8::EpiResid E{(bf16*)(ws + (f == 0 ? WS_OB : WS_HBA)), (bf16*)(ws + WS_HBA), (float*)(ws + WS_SSPA), rep == NREP(1) - 1 ? 0.5f : 0.f};
        pg8::gemm_phase<pg8::EpiResid, pg8::StaticOrder, MK_ALIGN1, MK_SP2>(RING, g, S, E, F.wave); }
    }
    SEAM(pf + 1);
}
template <int l> __device__ __forceinline__ void ph_mixer(Frame& F, const Ctl& C, unsigned char* lds) {
    constexpr int pb = 1 + 8 * l;
    if (INK(2, pb + 2)) {
        unsigned char* ws = WSB;
        pg8::Gemm g{(bf16*)(ws + WS_HBA), (bf16*)(ws + WS_WQKV + l * SZ_WQKV), M, 3 * DMODEL, DMODEL}; pg8::StaticOrder S; S.init(M, 3 * DMODEL, F.G, (int)blockIdx.x, MK_WGM_QKV);
        pg8::fill_rstd_table(RSL, (float*)(ws + WS_SSPA), S, F.wave, lane_id_v(), 3); asm volatile("s_waitcnt lgkmcnt(0)" ::: "memory"); __syncthreads();
        pg8::EpiQKV E{(bf16*)(ws + WS_QKV), (size_t)M * DMODEL, RSL, INP(l == 0 ? 8 : 14), INP(l == 0 ? 9 : 15), 0.125f * 1.4426950408889634f};
        if (NNULL(2)) { pg8::EpiNull EN; pg8::gemm_phase<pg8::EpiNull, pg8::StaticOrder, true, MK_SP2>(RING, g, S, EN, F.wave); }
#pragma unroll 1
        for (int rep = 0; rep < NREP(2); ++rep) pg8::gemm_phase<pg8::EpiQKV, pg8::StaticOrder, true, MK_SP2>(RING, g, S, E, F.wave);
    }
    SEAM(pb + 2);
    if (INK(3, pb + 3)) {
        unsigned char* ws = WSB;
        bf16* QB = (bf16*)(ws + WS_QKV); bf16* KB = QB + (size_t)M * DMODEL; bf16* VB = KB + (size_t)M * DMODEL; bf16* OB = (bf16*)(ws + WS_OB);
        if (l == 0 && (MK_ATT_SEL & 1)) {
            const float* t5 = INP(5); const float* qg = INP(8); const float* kg = INP(9); const float* lamp = INP(10);
#pragma unroll 1
            for (int i = 0; i < 4 * NREP(3); ++i) { int vc_ = F.vcu; asm volatile("" : "+s"(vc_)); const int bh = (i & 3) * 8 + (vc_ >> 5), qb = vc_ & 31;
                if (MK_ATT_PROBE && NREP(3) == 2 && i < 4) att::d_unit<MK_ATT_PROBE>(bh >> 3, bh & 7, qb, QB, KB, VB, OB, t5, qg, kg, lamp, (char*)lds + RING_OFF, (char*)lds + AUX_OFF, F.wave);
                else if (MK_ATT_STAG) att::d_unit_s<0>(bh >> 3, bh & 7, qb, QB, KB, VB, OB, t5, qg, kg, lamp, (char*)lds + RING_OFF, (char*)lds + AUX_OFF, F.wave);
                else att::d_unit<0>(bh >> 3, bh & 7, qb, QB, KB, VB, OB, t5, qg, kg, lamp, (char*)lds + RING_OFF, (char*)lds + AUX_OFF, F.wave); }
        } else if (l == 1 && (MK_ATT_SEL & 2)) {
            const float* rpb = INP(16);
            int vc_ = F.vcu; asm volatile("" : "+s"(vc_));
#ifndef MK_NA8
#define MK_NA8 1
#endif
            const int h = MK_NA8 ? (vc_ >> 3) & 15 : vc_ >> 4, rg = MK_NA8 ? vc_ & 7 : vc_ & 15, bhi = vc_ >> 7;
            { const int tid_ = F.wave * 64 + lane_id_v(); LAS float* tb = (LAS float*)(F.lds + AUX_OFF);
              for (int i = tid_; i < 465; i += NWAVES * 64) tb[i] = rpb[h * 465 + i] * 1.4426950408889634f; }
            if (MK_NA8) {
#pragma unroll 1
                for (int i = 0; i < 2 * NREP(5); ++i)
                    { if (MK_NA_PROBE && NREP(5) == 2 && i < 2) att::n_unit8<MK_NA_PROBE>(2 * (i & 1) + bhi, h, rg, QB, KB, VB, OB, (char*)lds + RING_OFF, (char*)lds + AUX_OFF, F.wave);
                      else att::n_unit8<0>(2 * (i & 1) + bhi, h, rg, QB, KB, VB, OB, (char*)lds + RING_OFF, (char*)lds + AUX_OFF, F.wave); }
            } else {
#pragma unroll 1
                for (int i = 0; i < 4 * NREP(5); ++i)
                    { if (MK_NA_PROBE && NREP(5) == 2 && i < 4) att::n_unit<MK_NA_PROBE>(i & 3, h, rg, QB, KB, VB, OB, (char*)lds + RING_OFF, (char*)lds + AUX_OFF, F.wave);
                      else att::n_unit<0>(i & 3, h, rg, QB, KB, VB, OB, (char*)lds + RING_OFF, (char*)lds + AUX_OFF, F.wave); }
            }
        }
    }
    SEAM(pb + 3);
    if (INK(4, pb + 4)) {
        unsigned char* ws = WSB; float* hout = HOUT;
        pg8::Gemm g{(bf16*)(ws + WS_OB), (bf16*)(ws + WS_WO + l * SZ_WSQ), M, DMODEL, DMODEL}; pg8::StaticOrder S; S.init(M, DMODEL, F.G, (int)blockIdx.x, MK_WGM_N1K);
        if (NNULL(4)) { pg8::EpiNull EN; pg8::gemm_phase<pg8::EpiNull, pg8::StaticOrder, true, MK_SP2>(RING, g, S, EN, F.wave); }
#pragma unroll 1
        for (int rep = 0; rep < NREP(4); ++rep) {
        pg8::EpiResid E{(bf16*)(ws + WS_HBA), (bf16*)(ws + WS_HBA), (float*)(ws + WS_SSPA), rep == NREP(4) - 1 ? 1.0f : 0.f};
        pg8::gemm_phase<pg8::EpiResid, pg8::StaticOrder, MK_ALIGN1, MK_SP2>(RING, g, S, E, F.wave); }
    }
    SEAM(pb + 4);
}
template <int l> __device__ __forceinline__ void ph_ple(Frame& F, const Ctl& C) {
    constexpr int pb = 1 + 8 * l;
    if (INK(7, pb + 7)) {
        if (MK_PLE_SEL & 1) { unsigned char* ws = WSB;
          pg8::Gemm g{(bf16*)(ws + WS_PB) + (size_t)l * M * PLE, (bf16*)(ws + WS_WP + l * SZ_WP), M, DMODEL, PLE}; pg8::StaticOrder S; S.init(M, DMODEL, F.G, (int)blockIdx.x, MK_WGM_N1K);
          pg8::EpiPlainBf16 E{(bf16*)(ws + WS_PROJ), DMODEL};
#pragma unroll 1
          for (int rep = 0; rep < NREP(7); ++rep) pg8::gemm_phase<pg8::EpiPlainBf16, pg8::StaticOrder, true, MK_SP2>(RING, g, S, E, F.wave); }
        if (MK_PLE_SEL & 2) { unsigned char* ws = WSB; float* hout = HOUT;
          pg8::Gemm g{(bf16*)(ws + WS_HBA), (bf16*)(ws + WS_WG + l * SZ_WSQ), M, DMODEL, DMODEL}; pg8::StaticOrder S; S.init(M, DMODEL, F.G, (int)blockIdx.x, MK_WGM_N1K);
          pg8::fill_rstd_table(RSL, (float*)(ws + WS_SSPA), S, F.wave, lane_id_v(), 1); asm volatile("s_waitcnt lgkmcnt(0)" ::: "memory"); __syncthreads();
#pragma unroll 1
          for (int rep = 0; rep < NREP(7); ++rep) {
          pg8::EpiPLE E{(bf16*)(ws + WS_HBA), (bf16*)(ws + WS_OB), l == DEPTH - 1 ? hout : nullptr, RSL, (float*)(ws + WS_SSPB), INP(18) + l * DMODEL, (bf16*)(ws + WS_PROJ), rep == NREP(7) - 1 ? 1.0f : 0.f};
          pg8::gemm_phase<pg8::EpiPLE, pg8::StaticOrder, MK_ALIGN1, MK_SP2>(RING, g, S, E, F.wave); } }
    }
    SEAM(pb + 7);
}
__global__ void __launch_bounds__(NWAVES * 64, 2) mk_fwd(Args args) {
    extern __shared__ __attribute__((aligned(16))) unsigned char lds[];
    Frame F;
    F.lds = (LAS unsigned char*)lds; F.MISC = (volatile LAS unsigned*)(F.lds + MISC_OFF);
    F.tid = threadIdx.x; F.wave = __builtin_amdgcn_readfirstlane(F.tid >> 6); F.lane = lane_id_v();
    F.G = gridDim.x; { const int bx = blockIdx.x; F.vcu = (F.G % 8 == 0) ? (bx % 8) * (F.G / 8) + bx / 8 : bx; }
    F.ctl = (gu32*)(args.ws + WS_CTL);
    for (int u = F.tid; u < (LDS_BYTES - LDSCTL_OFF) / 4; u += NWAVES * 64) ((LAS unsigned*)(F.lds + LDSCTL_OFF))[u] = 0u;
    __syncthreads();
    if (F.tid == 0) {
#pragma unroll
        for (int k = 0; k < 20; ++k) *(LAS unsigned long long*)(F.lds + PT_OFF + 8 * k) = (unsigned long long)(uintptr_t)args.in[k];
        *(LAS unsigned long long*)(F.lds + PT_OFF + 8 * 20) = (unsigned long long)(uintptr_t)args.out; *(LAS unsigned long long*)(F.lds + PT_OFF + 8 * 21) = (unsigned long long)(uintptr_t)args.ws; }
    __syncthreads();
    (void)xcd_barrier_post((unsigned*)(F.ctl + CW_BAR) + args.li * XCD_BAR_WORDS, F.MISC + 8, F.tid == 0);
    Ctl C{args.ph_lo, args.ph_hi, args.li, args.x_in_out};
    if (INK(8, 0)) {
#pragma unroll 1
        for (int rep = 0; rep < NREP(8); ++rep) p0_prologue(F, args); }
    SEAM(0);
    ph_ffn<0, 0>(F, C); ph_mixer<0>(F, C, lds); ph_ffn<0, 1>(F, C); ph_ple<0>(F, C);
    ph_ffn<1, 0>(F, C); ph_mixer<1>(F, C, lds); ph_ffn<1, 1>(F, C); ph_ple<1>(F, C);
}
#undef IN
#undef INK
#undef SEAM
#undef WSB
#undef HOUT
#undef RING
#undef RSL
#ifndef MK_MODE
#define MK_MODE 0
#endif
#if MK_MODE == 2
namespace base {
constexpr int D = 1024, BATCH = 4, SEQ = 4096, M = BATCH * SEQ, DFF = 2816, PLE = 256;
constexpr float EPS = 1e-6f;

template <int TB>
__global__ __launch_bounds__(256) void k_gemm(const float* __restrict__ A, int lda, const float* __restrict__ B, int ldb, float* __restrict__ C, int ldc, int K) {
    __shared__ float As[16][68];
    __shared__ float Bs[16][68];
    const int tid = threadIdx.x, tx = tid & 15, ty = tid >> 4;
    const int m0 = blockIdx.y * 64, n0 = blockIdx.x * 64;
    float acc[4][4];
#pragma unroll
    for (int i = 0; i < 4; ++i)
#pragma unroll
        for (int j = 0; j < 4; ++j) acc[i][j] = 0.f;
    for (int k0 = 0; k0 < K; k0 += 16) {
        {
            const int r = tid >> 2, kk = (tid & 3) * 4;
            const float4 v = *(const float4*)(A + (size_t)(m0 + r) * lda + k0 + kk);
            As[kk + 0][r] = v.x; As[kk + 1][r] = v.y; As[kk + 2][r] = v.z; As[kk + 3][r] = v.w;
        }
        if (TB == 0) {
            const int kk = tid >> 4, nn = (tid & 15) * 4;
            const float4 v = *(const float4*)(B + (size_t)(k0 + kk) * ldb + n0 + nn);
            Bs[kk][nn + 0] = v.x; Bs[kk][nn + 1] = v.y; Bs[kk][nn + 2] = v.z; Bs[kk][nn + 3] = v.w;
        } else {
            const int nn = tid >> 2, kk = (tid & 3) * 4;
            const float4 v = *(const float4*)(B + (size_t)(n0 + nn) * ldb + k0 + kk);
            Bs[kk + 0][nn] = v.x; Bs[kk + 1][nn] = v.y; Bs[kk + 2][nn] = v.z; Bs[kk + 3][nn] = v.w;
        }
        __syncthreads();
#pragma unroll
        for (int kk = 0; kk < 16; ++kk) {
            float a[4], b[4];
#pragma unroll
            for (int i = 0; i < 4; ++i) a[i] = As[kk][ty * 4 + i];
#pragma unroll
            for (int j = 0; j < 4; ++j) b[j] = Bs[kk][tx * 4 + j];
#pragma unroll
            for (int i = 0; i < 4; ++i)
#pragma unroll
                for (int j = 0; j < 4; ++j) acc[i][j] = fmaf(a[i], b[j], acc[i][j]);
        }
        __syncthreads();
    }
#pragma unroll
    for (int i = 0; i < 4; ++i) {
        float4 v = {acc[i][0], acc[i][1], acc[i][2], acc[i][3]};
        *(float4*)(C + (size_t)(m0 + ty * 4 + i) * ldc + n0 + tx * 4) = v;
    }
}

__device__ __forceinline__ float wave_sum(float v) {
#pragma unroll
    for (int o = 1; o < 64; o <<= 1) v += __shfl_xor(v, o);
    return v;
}
__device__ __forceinline__ float wave_max(float v) {
#pragma unroll
    for (int o = 1; o < 64; o <<= 1) v = fmaxf(v, __shfl_xor(v, o));
    return v;
}

__global__ __launch_bounds__(256) void k_rmsnorm(const float* __restrict__ x, const float* __restrict__ gain, float* __restrict__ y, int rows) {
    const int lane = threadIdx.x & 63, row = blockIdx.x * 4 + (threadIdx.x >> 6);
    if (row >= rows) return;
    const float* xr = x + (size_t)row * D; float* yr = y + (size_t)row * D;
    float v[16]; float ss = 0.f;
#pragma unroll
    for (int j = 0; j < 16; ++j) { v[j] = xr[lane + 64 * j]; ss += v[j] * v[j]; }
    ss = wave_sum(ss);
    const float r = 1.0f / sqrtf(ss * (1.0f / D) + EPS);
#pragma unroll
    for (int j = 0; j < 16; ++j) yr[lane + 64 * j] = v[j] * r * gain[lane + 64 * j];
}
__global__ __launch_bounds__(256) void k_swiglu(const float* __restrict__ gu, float* __restrict__ hid, int rows) {
    const size_t n = (size_t)rows * DFF;
    for (size_t i = blockIdx.x * 256ull + threadIdx.x; i < n; i += gridDim.x * 256ull) {
        const size_t r = i / DFF, j = i % DFF;
        const float g = gu[r * (2 * DFF) + j], u = gu[r * (2 * DFF) + DFF + j];
        hid[i] = g / (1.0f + expf(-g)) * u;
    }
}
__global__ __launch_bounds__(256) void k_axpy(float* __restrict__ h, const float* __restrict__ y, float alpha, size_t n) {
    for (size_t i = blockIdx.x * 256ull + threadIdx.x; i < n; i += gridDim.x * 256ull) h[i] += alpha * y[i];
}
__global__ __launch_bounds__(256) void k_headnorm(float* __restrict__ x, int ld, int col0, int nheads, const float* __restrict__ gain, float scale, int rows) {
    const int lane = threadIdx.x & 63, row = blockIdx.x * 4 + (threadIdx.x >> 6);
    if (row >= rows) return;
    float* xr = x + (size_t)row * ld + col0;
    const float g = gain[lane] * scale;
    for (int h = 0; h < nheads; ++h) {
        const float v = xr[h * 64 + lane];
        const float ss = wave_sum(v * v);
        xr[h * 64 + lane] = v * (1.0f / sqrtf(ss * (1.0f / 64.0f) + EPS)) * g;
    }
}
__device__ __forceinline__ int t5_bucket(int rel) {
    const int n = rel < 0 ? -rel : rel;
    int b;
    if (n < 8) b = n;
    else { int l = 2 + (31 - __clz(n * n)); b = l < 15 ? l : 15; }
    return b + (rel > 0 ? 16 : 0);
}
__global__ __launch_bounds__(256) void k_softmax_diff(float* __restrict__ S0, const float* __restrict__ S1, const float* __restrict__ table, int head, const float* __restrict__ lamp) {
    __shared__ float red[8];
    __shared__ float tb[32];
    const int q = blockIdx.x, tid = threadIdx.x, lane = tid & 63, w = tid >> 6;
    if (tid < 32) tb[tid] = table[tid * 8 + head];
    float d01 = 0.f, d23 = 0.f;
    if (tid < 64) { d01 = lamp[tid] * lamp[64 + tid]; d23 = lamp[128 + tid] * lamp[192 + tid]; }
    __syncthreads();
    float* s0 = S0 + (size_t)q * SEQ; const float* s1 = S1 + (size_t)q * SEQ;
    float a[16], b[16];
    float m0 = -1e30f, m1 = -1e30f;
#pragma unroll
    for (int j = 0; j < 16; ++j) { const int k = tid + 256 * j; const float bi = tb[t5_bucket(k - q)]; a[j] = s0[k] + bi; b[j] = s1[k] + bi; m0 = fmaxf(m0, a[j]); m1 = fmaxf(m1, b[j]); }
    m0 = wave_max(m0); m1 = wave_max(m1);
    if (lane == 0) { red[w] = m0; red[4 + w] = m1; }
    __syncthreads();
    m0 = fmaxf(fmaxf(red[0], red[1]), fmaxf(red[2], red[3])); m1 = fmaxf(fmaxf(red[4], red[5]), fmaxf(red[6], red[7]));
    __syncthreads();
    float l0 = 0.f, l1 = 0.f;
#pragma unroll
    for (int j = 0; j < 16; ++j) { a[j] = expf(a[j] - m0); b[j] = expf(b[j] - m1); l0 += a[j]; l1 += b[j]; }
    l0 = wave_sum(l0); l1 = wave_sum(l1);
    if (lane == 0) { red[w] = l0; red[4 + w] = l1; }
    __syncthreads();
    l0 = (red[0] + red[1]) + (red[2] + red[3]); l1 = (red[4] + red[5]) + (red[6] + red[7]);
    __syncthreads();
    d01 = wave_sum(d01); d23 = wave_sum(d23);
    if (tid == 0) red[0] = expf(d01) - expf(d23) + 0.2f;
    __syncthreads();
    const float lam = red[0];
    const float i0 = 1.0f / l0, i1 = lam / l1;
#pragma unroll
    for (int j = 0; j < 16; ++j) s0[tid + 256 * j] = a[j] * i0 - b[j] * i1;
}
__global__ __launch_bounds__(256) void k_subln(float* __restrict__ o, const float* __restrict__ gain, int rows) {
    const int lane = threadIdx.x & 63, row = blockIdx.x * 4 + (threadIdx.x >> 6);
    if (row >= rows) return;
    float* orow = o + (size_t)row * D;
    for (int h = 0; h < 8; ++h) {
        const float v0 = orow[h * 128 + lane], v1 = orow[h * 128 + 64 + lane];
        const float ss = wave_sum(v0 * v0 + v1 * v1);
        const float r = (1.0f / sqrtf(ss * (1.0f / 128.0f) + EPS)) * 0.8f;
        orow[h * 128 + lane] = v0 * r * gain[lane]; orow[h * 128 + 64 + lane] = v1 * r * gain[64 + lane];
    }
}
__global__ __launch_bounds__(256) void k_na(const float* __restrict__ qkv, const float* __restrict__ rpb, float* __restrict__ out) {
    const int lane = threadIdx.x & 63, gw = blockIdx.x * 4 + (threadIdx.x >> 6);
    const int t = gw >> 4, h = gw & 15;
    if (t >= SEQ) return;
    const int r = t >> 6, c = t & 63;
    int rs = r - 4; rs = rs < 0 ? 0 : (rs > 56 ? 56 : rs);
    int cs = c - 8; cs = cs < 0 ? 0 : (cs > 48 ? 48 : cs);
    const float qd = qkv[(size_t)t * 3072 + h * 64 + lane];
    float m = -1e30f, l = 0.f, acc = 0.f;
    for (int i = 0; i < 8; ++i)
        for (int j = 0; j < 16; ++j) {
            const int kr = rs + i, kc = cs + j, kt = kr * 64 + kc;
            const float kd = qkv[(size_t)kt * 3072 + 1024 + h * 64 + lane];
            float s = wave_sum(qd * kd) + rpb[(h * 15 + (kr - r + 7)) * 31 + (kc - c + 15)];
            const float mn = fmaxf(m, s), f = expf(m - mn), p = expf(s - mn);
            const float vd = qkv[(size_t)kt * 3072 + 2048 + h * 64 + lane];
            l = l * f + p; acc = acc * f + p * vd; m = mn;
        }
    out[(size_t)t * D + h * 64 + lane] = acc / l;
}
__global__ __launch_bounds__(256) void k_ple(float* __restrict__ h, const float* __restrict__ g, const float* __restrict__ bias, const float* __restrict__ pr, size_t n) {
    for (size_t i = blockIdx.x * 256ull + threadIdx.x; i < n; i += gridDim.x * 256ull) {
        const float z = g[i] + bias[i & (D - 1)];
        h[i] += pr[i] / (1.0f + expf(-z));
    }
}

static void gemm(hipStream_t st, int TB, const float* A, int lda, const float* B, int ldb, float* C, int ldc, int Mr, int N, int K) {
    dim3 grid(N / 64, Mr / 64);
    if (TB == 0) hipLaunchKernelGGL(k_gemm<0>, grid, dim3(256), 0, st, A, lda, B, ldb, C, ldc, K);
    else         hipLaunchKernelGGL(k_gemm<1>, grid, dim3(256), 0, st, A, lda, B, ldb, C, ldc, K);
}
}
#endif
#ifndef MK_MODE
#define MK_MODE 0
#endif
#ifndef MK_OPT_MASK
#define MK_OPT_MASK 0xff
#endif
constexpr int N_PHASES = 1 + 8 * DEPTH;

#if MK_MODE == 2
namespace base {
struct Ctx { hipStream_t st; float *hn, *gu, *hid, *y, *qkv, *ob, *gg, *pr, *S0, *S1; void* const* d_in; float* h; };
static void ffn(const Ctx& c, int i, int f) {
    const float* ng = (const float*)c.d_in[2]; const float* w_in = (const float*)c.d_in[3]; const float* w_out = (const float*)c.d_in[4];
    const size_t R = SEQ;
    for (int b = 0; b < BATCH; ++b) { float* hb = c.h + (size_t)b * R * D;
        hipLaunchKernelGGL(k_rmsnorm, dim3(R / 4), dim3(256), 0, c.st, hb, ng + (i * 4 + (f == 0 ? 0 : 2)) * D, c.hn, (int)R);
        gemm(c.st, 0, c.hn, D, w_in + (size_t)(i * 2 + f) * D * 2 * DFF, 2 * DFF, c.gu, 2 * DFF, R, 2 * DFF, D);
        hipLaunchKernelGGL(k_swiglu, dim3(2048), dim3(256), 0, c.st, c.gu, c.hid, (int)R);
        gemm(c.st, 0, c.hid, DFF, w_out + (size_t)(i * 2 + f) * DFF * D, D, c.y, D, R, D, DFF);
        hipLaunchKernelGGL(k_axpy, dim3(2048), dim3(256), 0, c.st, hb, c.y, 0.5f, R * D); }
}
static void mixer(const Ctx& c, int i) {
    const float* ng = (const float*)c.d_in[2]; const size_t R = SEQ;
    for (int b = 0; b < BATCH; ++b) { float* hb = c.h + (size_t)b * R * D;
        hipLaunchKernelGGL(k_rmsnorm, dim3(R / 4), dim3(256), 0, c.st, hb, ng + (i * 4 + 1) * D, c.hn, (int)R);
        if (i == 0) {
            gemm(c.st, 0, c.hn, D, (const float*)c.d_in[6], 3 * D, c.qkv, 3 * D, R, 3 * D, D);
            hipLaunchKernelGGL(k_headnorm, dim3(R / 4), dim3(256), 0, c.st, c.qkv, 3 * D, 0, 16, (const float*)c.d_in[8], 0.125f, (int)R);
            hipLaunchKernelGGL(k_headnorm, dim3(R / 4), dim3(256), 0, c.st, c.qkv, 3 * D, D, 16, (const float*)c.d_in[9], 1.0f, (int)R);
            for (int hh = 0; hh < 8; ++hh) {
                gemm(c.st, 1, c.qkv + hh * 128, 3 * D, c.qkv + D + hh * 128, 3 * D, c.S0, SEQ, SEQ, SEQ, 64);
                gemm(c.st, 1, c.qkv + hh * 128 + 64, 3 * D, c.qkv + D + hh * 128 + 64, 3 * D, c.S1, SEQ, SEQ, SEQ, 64);
                hipLaunchKernelGGL(k_softmax_diff, dim3(SEQ), dim3(256), 0, c.st, c.S0, c.S1, (const float*)c.d_in[5], hh, (const float*)c.d_in[10]);
                gemm(c.st, 0, c.S0, SEQ, c.qkv + 2 * D + hh * 128, 3 * D, c.ob + hh * 128, D, SEQ, 128, SEQ); }
            hipLaunchKernelGGL(k_subln, dim3(R / 4), dim3(256), 0, c.st, c.ob, (const float*)c.d_in[11], (int)R);
            gemm(c.st, 0, c.ob, D, (const float*)c.d_in[7], D, c.y, D, R, D, D);
        } else {
            gemm(c.st, 0, c.hn, D, (const float*)c.d_in[12], 3 * D, c.qkv, 3 * D, R, 3 * D, D);
            hipLaunchKernelGGL(k_headnorm, dim3(R / 4), dim3(256), 0, c.st, c.qkv, 3 * D, 0, 16, (const float*)c.d_in[14], 0.125f, (int)R);
            hipLaunchKernelGGL(k_headnorm, dim3(R / 4), dim3(256), 0, c.st, c.qkv, 3 * D, D, 16, (const float*)c.d_in[15], 1.0f, (int)R);
            hipLaunchKernelGGL(k_na, dim3(SEQ * 16 / 4), dim3(256), 0, c.st, c.qkv, (const float*)c.d_in[16], c.ob);
            gemm(c.st, 0, c.ob, D, (const float*)c.d_in[13], D, c.y, D, R, D, D);
        }
        hipLaunchKernelGGL(k_axpy, dim3(2048), dim3(256), 0, c.st, hb, c.y, 1.0f, R * D); }
}
static void ple(const Ctx& c, int i) {
    const float* ng = (const float*)c.d_in[2]; const size_t R = SEQ; const float* p = (const float*)c.d_in[1];
    for (int b = 0; b < BATCH; ++b) { float* hb = c.h + (size_t)b * R * D;
        hipLaunchKernelGGL(k_rmsnorm, dim3(R / 4), dim3(256), 0, c.st, hb, ng + (i * 4 + 3) * D, c.hn, (int)R);
        gemm(c.st, 0, c.hn, D, (const float*)c.d_in[17] + (size_t)i * D * D, D, c.gg, D, R, D, D);
        gemm(c.st, 0, p + ((size_t)i * M + (size_t)b * R) * PLE, PLE, (const float*)c.d_in[19] + (size_t)i * PLE * D, D, c.pr, D, R, D, PLE);
        hipLaunchKernelGGL(k_ple, dim3(2048), dim3(256), 0, c.st, hb, c.gg, (const float*)c.d_in[18] + i * D, c.pr, R * D); }
}
}
#endif

extern "C" void kernel_launch(void* const* d_in, const int* in_sizes, int n_in, void* d_out, int out_size, void* d_ws, size_t ws_size, hipStream_t stream) {
    static int grid = 0;
    if (grid == 0) {
        if (n_in != 20 || in_sizes[0] != M * DMODEL || out_size != M * DMODEL || ws_size < WS_END) { fprintf(stderr, "kernel_launch: unexpected shapes / workspace (ws %zu, need %zu); nothing launched\n", ws_size, (size_t)WS_END); grid = -1; return; }
        int dev = 0, cus = 0;
        if (hipGetDevice(&dev) != hipSuccess || hipDeviceGetAttribute(&cus, hipDeviceAttributeMultiprocessorCount, dev) != hipSuccess) { grid = -1; return; }
        if (hipFuncSetAttribute((const void*)mk_fwd, hipFuncAttributeMaxDynamicSharedMemorySize, LDS_BYTES) != hipSuccess) { fprintf(stderr, "kernel_launch: hipFuncSetAttribute failed\n"); grid = -1; return; }
        int per_cu = 0; (void)hipOccupancyMaxActiveBlocksPerMultiprocessor(&per_cu, (const void*)mk_fwd, NWAVES * 64, LDS_BYTES); (void)hipGetLastError();
        grid = cus;
        if (grid != 256) fprintf(stderr, "kernel_launch: %d CUs; the unit maps assume 256\n", grid);
    }
    if (grid < 0) return;
    (void)hipMemsetAsync((char*)d_ws + WS_CTL, 0, CTL_ZERO_BYTES, stream);
    Args a{};
    for (int i = 0; i < 20; ++i) a.in[i] = (const float*)d_in[i];
    a.out = (float*)d_out; a.ws = (unsigned char*)d_ws;
#if MK_MODE == 0
    a.ph_lo = 0; a.ph_hi = N_PHASES; a.li = 0; a.x_in_out = 0; a.hb_sel = 0;
    hipLaunchKernelGGL(mk_fwd, dim3(grid), dim3(NWAVES * 64), LDS_BYTES, stream, a);
#elif MK_MODE == 1
    for (int ph = 0; ph < N_PHASES; ++ph) { a.ph_lo = ph; a.ph_hi = ph + 1; a.li = 0; a.x_in_out = 0; a.hb_sel = 0;
        hipLaunchKernelGGL(mk_fwd, dim3(grid), dim3(NWAVES * 64), LDS_BYTES, stream, a); }
#else
    {
        using namespace base;
        (void)hipMemcpyAsync(d_out, d_in[0], (size_t)M * DMODEL * sizeof(float), hipMemcpyDeviceToDevice, stream);
        float* wsf = (float*)((char*)d_ws + MiB); const size_t R = SEQ;
        Ctx c; c.st = stream; c.d_in = d_in; c.h = (float*)d_out;
        c.hn = wsf; c.gu = c.hn + R * D; c.hid = c.gu + R * 2 * base::DFF; c.y = c.hid + R * base::DFF; c.qkv = c.y + R * D; c.ob = c.qkv + R * 3 * D; c.gg = c.ob + R * D; c.pr = c.gg + R * D;
        c.S0 = c.gu; c.S1 = c.gu + (size_t)SEQ * SEQ;
        int li = 0;
        for (int sb = 0; sb < 8; ++sb) {
            const int l = sb >> 2, kind = sb & 3;
            if ((MK_OPT_MASK >> sb) & 1) {
                const int pb = 1 + 8 * l; int lo, hi;
                if (kind == 0) { lo = pb; hi = pb + 2; } else if (kind == 1) { lo = pb + 2; hi = pb + 5; } else if (kind == 2) { lo = pb + 5; hi = pb + 7; } else { lo = pb + 7; hi = pb + 8; }
                a.x_in_out = 1; a.hb_sel = kind == 0 ? 0 : 1;
                a.ph_lo = 0; a.ph_hi = 1; a.li = li++;
                hipLaunchKernelGGL(mk_fwd, dim3(grid), dim3(NWAVES * 64), LDS_BYTES, stream, a);
                a.ph_lo = lo; a.ph_hi = hi; a.li = li++;
                hipLaunchKernelGGL(mk_fwd, dim3(grid), dim3(NWAVES * 64), LDS_BYTES, stream, a);
            } else {
                if (kind == 0) ffn(c, l, 0); else if (kind == 1) mixer(c, l); else if (kind == 2) ffn(c, l, 1); else ple(c, l);
            }
        }
    }
#endif
}
```
